# Optimizing an MI355X kernel written in HIP

```python
import jax, jax.numpy as jnp
from jax import lax
import numpy as np

D_MODEL = 1024
BATCH = 4
SEQ = 4096
DEPTH = 1

GRID_W = 64

NA_HEADS = 8
NA_HEAD_DIM = 64
NA_WIDTH = NA_HEADS * NA_HEAD_DIM
NA_WIN_ROWS_MAX = 8
NA_WIN_COLS = 16

MLA_HEADS = 8
MLA_Q_LORA = 256
MLA_KV_LORA = 128
MLA_NOPE_DIM = 64
MLA_ROPE_DIM = 32
MLA_QK_DIM = MLA_NOPE_DIM + MLA_ROPE_DIM
MLA_V_DIM = 64
MLA_WIDTH = MLA_HEADS * MLA_V_DIM
MLA_Q_BLOCK = 128
ROPE_THETA = 10000.0

IN_SIZES = (NA_WIDTH, NA_WIDTH, NA_WIDTH, MLA_Q_LORA, MLA_KV_LORA, MLA_ROPE_DIM, D_MODEL, D_MODEL)
IN_TOTAL = 3 * NA_WIDTH + MLA_Q_LORA + MLA_KV_LORA + MLA_ROPE_DIM + 2 * D_MODEL

FFN_HIDDEN = -(-8 * D_MODEL // (3 * 256)) * 256

DN_ALPHA = (2.0 * DEPTH) ** 0.25
DN_BETA = (8.0 * DEPTH) ** -0.25
LN_EPS = 1e-5
RMS_EPS = 1e-6

kernel_name = "hybrid_na2d_mla_gated_deepnorm_encoder"


def layer_norm(x, g, b):
    xf = x.astype(jnp.float32)
    mu = jnp.mean(xf, axis=-1, keepdims=True)
    var = jnp.mean(jnp.square(xf - mu), axis=-1, keepdims=True)
    y = (xf - mu) * lax.rsqrt(var + LN_EPS) * g.astype(jnp.float32) + b.astype(jnp.float32)
    return y.astype(x.dtype)


def rms_norm(x, g):
    xf = x.astype(jnp.float32)
    y = xf * lax.rsqrt(jnp.mean(jnp.square(xf), axis=-1, keepdims=True) + RMS_EPS) * g.astype(jnp.float32)
    return y.astype(x.dtype)


def axial_rope_tables(seq_len):
    t = jnp.arange(seq_len)
    rows = (t // GRID_W).astype(jnp.float32)
    cols = (t % GRID_W).astype(jnp.float32)
    half = MLA_ROPE_DIM // 2
    inv_freq = ROPE_THETA ** (-jnp.arange(0, half, 2, dtype=jnp.float32) / half)
    ang_r = rows[:, None, None] * inv_freq
    ang_c = cols[:, None, None] * inv_freq
    return jnp.cos(ang_r), jnp.sin(ang_r), jnp.cos(ang_c), jnp.sin(ang_c)


def rotate_pairs(x, cos, sin):
    x1, x2 = jnp.split(x, 2, axis=-1)
    return jnp.concatenate([x1 * cos - x2 * sin, x2 * cos + x1 * sin], axis=-1)


def apply_axial_rope(x, tables):
    cos_r, sin_r, cos_c, sin_c = tables
    xf = x.astype(jnp.float32)
    xr, xc = jnp.split(xf, 2, axis=-1)
    out = jnp.concatenate([rotate_pairs(xr, cos_r, sin_r), rotate_pairs(xc, cos_c, sin_c)], axis=-1)
    return out.astype(x.dtype)


def neighbourhood_attention_2d(q, k, v, rpb):
    B, S, H, dh = q.shape
    rows = S // GRID_W
    kr = min(NA_WIN_ROWS_MAX, rows)
    kc = NA_WIN_COLS
    qg = q.reshape(B, rows, GRID_W, H, dh).transpose(1, 0, 2, 3, 4)
    kg = k.reshape(B, rows, GRID_W, H, dh)
    vg = v.reshape(B, rows, GRID_W, H, dh)
    col = jnp.arange(GRID_W)
    col_start = jnp.clip(col - kc // 2, 0, GRID_W - kc)
    col_idx = col_start[:, None] + jnp.arange(kc)[None, :]
    col_bias_idx = col_idx - col[:, None] + (NA_WIN_COLS - 1)
    rpb_cols = rpb.astype(jnp.float32)[:, :, col_bias_idx]
    scale = dh ** -0.5

    def one_row(args):
        r, q_row = args
        r_start = jnp.clip(r - kr // 2, 0, rows - kr)
        k_band = lax.dynamic_slice_in_dim(kg, r_start, kr, axis=1)
        v_band = lax.dynamic_slice_in_dim(vg, r_start, kr, axis=1)
        k_nb = k_band[:, :, col_idx]
        v_nb = v_band[:, :, col_idx]
        row_bias_idx = r_start + jnp.arange(kr) - r + (NA_WIN_ROWS_MAX - 1)
        bias = rpb_cols[:, row_bias_idx].transpose(0, 2, 1, 3)
        s = jnp.einsum('bqhd,brqchd->bhqrc', q_row, k_nb).astype(jnp.float32) * scale + bias[None]
        p = jax.nn.softmax(s.reshape(B, H, GRID_W, kr * kc), axis=-1).reshape(B, H, GRID_W, kr, kc)
        return jnp.einsum('bhqrc,brqchd->bqhd', p.astype(v.dtype), v_nb)

    out = lax.map(one_row, (jnp.arange(rows), qg))
    return out.transpose(1, 0, 2, 3, 4).reshape(B, S, H * dh)


def latent_attention(q_lat, kv_lat, k_rope, q_norm_g, w_uq, kv_norm_g, w_ukv, tables):
    B, S, _ = q_lat.shape
    H = MLA_HEADS
    q = (rms_norm(q_lat, q_norm_g) @ w_uq).reshape(B, S, H, MLA_QK_DIM)
    q_nope, q_pe = jnp.split(q, [MLA_NOPE_DIM], axis=-1)
    q = jnp.concatenate([q_nope, apply_axial_rope(q_pe, tables)], axis=-1)
    kv = (rms_norm(kv_lat, kv_norm_g) @ w_ukv).reshape(B, S, H, MLA_NOPE_DIM + MLA_V_DIM)
    k_nope, v = jnp.split(kv, [MLA_NOPE_DIM], axis=-1)
    k_pe = apply_axial_rope(k_rope[:, :, None, :], tables)
    k = jnp.concatenate([k_nope, jnp.broadcast_to(k_pe, (B, S, H, MLA_ROPE_DIM))], axis=-1)
    scale = MLA_QK_DIM ** -0.5
    n_blk = S // MLA_Q_BLOCK
    qb = q.reshape(B, n_blk, MLA_Q_BLOCK, H, MLA_QK_DIM).transpose(1, 0, 2, 3, 4)

    def one_block(q_blk):
        s = jnp.einsum('bqhd,bkhd->bhqk', q_blk, k).astype(jnp.float32) * scale
        p = jax.nn.softmax(s, axis=-1)
        return jnp.einsum('bhqk,bkhd->bqhd', p.astype(v.dtype), v)

    o = lax.map(one_block, qb)
    return o.transpose(1, 0, 2, 3, 4).reshape(B, S, H * MLA_V_DIM)


def hybrid_mixer(x, w_in, b_gate, na_rpb, mla_q_norm, mla_w_uq, mla_kv_norm, mla_w_ukv,
                 w_branch_na, w_branch_mla, w_out, tables):
    B, S, _ = x.shape
    h = x @ w_in
    offs = [int(o) for o in np.cumsum(IN_SIZES)[:-1]]
    q_na, k_na, v_na, q_lat, kv_lat, k_rope, g_a, g_b = jnp.split(h, offs, axis=-1)
    shp = (B, S, NA_HEADS, NA_HEAD_DIM)
    y_a = neighbourhood_attention_2d(q_na.reshape(shp), k_na.reshape(shp), v_na.reshape(shp), na_rpb) @ w_branch_na
    y_b = latent_attention(q_lat, kv_lat, k_rope, mla_q_norm, mla_w_uq, mla_kv_norm, mla_w_ukv, tables) @ w_branch_mla
    b_a, b_b = jnp.split(b_gate, 2, axis=-1)
    merged = jax.nn.sigmoid(g_a + b_a) * y_a + jax.nn.sigmoid(g_b + b_b) * y_b
    return merged @ w_out


def swiglu(x, w_ffn_in, w_ffn_out):
    gate, up = jnp.split(x @ w_ffn_in, 2, axis=-1)
    return (jax.nn.silu(gate) * up) @ w_ffn_out


def setup_inputs(seed: int = 0) -> dict:
    key = jax.random.key(seed)
    ks = jax.random.split(key, 18)
    nrm = jax.random.normal
    f32 = jnp.float32
    L = DEPTH
    return {
        "x": nrm(ks[0], (BATCH, SEQ, D_MODEL), f32),
        "w_in": nrm(ks[1], (L, D_MODEL, IN_TOTAL), f32) * D_MODEL ** -0.5,
        "b_gate": nrm(ks[2], (L, 2 * D_MODEL), f32) * 0.01,
        "na_rpb": nrm(ks[3], (L, NA_HEADS, 2 * NA_WIN_ROWS_MAX - 1, 2 * NA_WIN_COLS - 1), f32) * 0.02,
        "mla_q_norm": 1.0 + 0.01 * nrm(ks[4], (L, MLA_Q_LORA), f32),
        "mla_w_uq": nrm(ks[5], (L, MLA_Q_LORA, MLA_HEADS * MLA_QK_DIM), f32) * MLA_Q_LORA ** -0.5,
        "mla_kv_norm": 1.0 + 0.01 * nrm(ks[6], (L, MLA_KV_LORA), f32),
        "mla_w_ukv": nrm(ks[7], (L, MLA_KV_LORA, MLA_HEADS * (MLA_NOPE_DIM + MLA_V_DIM)), f32) * MLA_KV_LORA ** -0.5,
        "w_branch_na": nrm(ks[8], (L, NA_WIDTH, D_MODEL), f32) * (NA_WIDTH ** -0.5 * DN_BETA),
        "w_branch_mla": nrm(ks[9], (L, MLA_WIDTH, D_MODEL), f32) * (MLA_WIDTH ** -0.5 * DN_BETA),
        "w_out": nrm(ks[10], (L, D_MODEL, D_MODEL), f32) * (D_MODEL ** -0.5 * DN_BETA),
        "ln1_g": 1.0 + 0.01 * nrm(ks[11], (L, D_MODEL), f32),
        "ln1_b": 0.01 * nrm(ks[12], (L, D_MODEL), f32),
        "w_ffn_in": nrm(ks[13], (L, D_MODEL, 2 * FFN_HIDDEN), f32) * D_MODEL ** -0.5,
        "w_ffn_out": nrm(ks[14], (L, FFN_HIDDEN, D_MODEL), f32) * (FFN_HIDDEN ** -0.5 * DN_BETA),
        "ln2_g": 1.0 + 0.01 * nrm(ks[15], (L, D_MODEL), f32),
        "ln2_b": 0.01 * nrm(ks[16], (L, D_MODEL), f32),
    }


def reference(x, w_in, b_gate, na_rpb, mla_q_norm, mla_w_uq, mla_kv_norm, mla_w_ukv,
              w_branch_na, w_branch_mla, w_out, ln1_g, ln1_b, w_ffn_in, w_ffn_out, ln2_g, ln2_b):
    tables = axial_rope_tables(x.shape[1])
    for l in range(DEPTH):
        m = hybrid_mixer(x, w_in[l], b_gate[l], na_rpb[l], mla_q_norm[l], mla_w_uq[l],
                         mla_kv_norm[l], mla_w_ukv[l], w_branch_na[l], w_branch_mla[l], w_out[l], tables)
        x = layer_norm(DN_ALPHA * x + m, ln1_g[l], ln1_b[l])
        x = layer_norm(DN_ALPHA * x + swiglu(x, w_ffn_in[l], w_ffn_out[l]), ln2_g[l], ln2_b[l])
    return x
```

```cpp
#include <hip/hip_runtime.h>
#include <hip/hip_cooperative_groups.h>
#include <cstdint>
#include <cstdio>
namespace cg = cooperative_groups;

#ifndef FUSED
#define FUSED 0
#endif

typedef unsigned short bf16_t;
typedef short bf16x8 __attribute__((ext_vector_type(8)));
typedef float f32x4 __attribute__((ext_vector_type(4)));
typedef unsigned u32x4 __attribute__((ext_vector_type(4)));
typedef unsigned u32x2 __attribute__((ext_vector_type(2)));

constexpr int M = 16384, DM = 1024, SEQ = 4096, GRIDW = 64;
constexpr int NAH = 8, NAD = 64;
constexpr int QLORA = 256, KVLORA = 128, ROPE = 32, NOPE = 64, QK = 96, VD = 64, MH = 8;
constexpr int FFH = 2816;
constexpr int HP = 4096;
constexpr float LOG2E = 1.4426950408889634f;
constexpr float DN_ALPHA = 1.189207115002721f;
constexpr float LN_EPS = 1e-5f, RMS_EPS = 1e-6f;

constexpr size_t MiB = 1u << 20;
constexpr size_t WS_CTL = 0;
constexpr size_t WS_ROPE = 64 * 1024;
constexpr size_t WS_WIN = 1 * MiB;
constexpr size_t WS_WUQ = 9 * MiB;
constexpr size_t WS_WUKV = 9 * MiB + 512 * 1024;
constexpr size_t WS_WBNA = 10 * MiB;
constexpr size_t WS_WBMLA = 11 * MiB;
constexpr size_t WS_WOUT = 12 * MiB;
constexpr size_t WS_WFI = 14 * MiB;
constexpr size_t WS_WFO = 25 * MiB;
constexpr size_t WS_XB = 32 * MiB;
constexpr size_t WS_QM = 32 * MiB;
constexpr size_t WS_KPE = 56 * MiB;
constexpr size_t WS_MG = 32 * MiB;
constexpr size_t WS_QKV = 64 * MiB;
constexpr size_t WS_X1B = 64 * MiB;
constexpr size_t WS_LAT = 112 * MiB;
constexpr size_t WS_G = 128 * MiB;
constexpr size_t WS_HID = 128 * MiB;
constexpr size_t WS_KVM = 192 * MiB;
constexpr size_t WS_QLN = 224 * MiB;
constexpr size_t WS_KVLN = 232 * MiB;
constexpr size_t WS_AO = 224 * MiB;
constexpr size_t WS_END = 256 * MiB;

struct Params {
    const float *x, *w_in, *b_gate, *rpb, *qn, *w_uq, *kvn, *w_ukv, *w_bna, *w_bmla, *w_out, *ln1g, *ln1b, *w_fi, *w_fo, *ln2g, *ln2b;
    float* out; unsigned char* ws;
};

__device__ __forceinline__ unsigned f2bf(float f) { unsigned u = __builtin_bit_cast(unsigned, f); return (u + 0x7fffu + ((u >> 16) & 1u)) >> 16; }
__device__ __forceinline__ float bf2f(unsigned b) { return __builtin_bit_cast(float, b << 16); }
__device__ __forceinline__ unsigned pk2(float lo, float hi) { return f2bf(lo) | (f2bf(hi) << 16); }
__device__ __forceinline__ float wave_sum(float v) {
#pragma unroll
    for (int o = 1; o < 64; o <<= 1) v += __shfl_xor(v, o);
    return v;
}
__device__ __forceinline__ float sigmoidf_(float z) { return 1.f / (1.f + __expf(-z)); }
__device__ __forceinline__ int rope_perm(int p) { return (p >> 4) * 16 + (p & 1) * 8 + ((p & 15) >> 1); }

__device__ __forceinline__ int colmap(int mode, int n) {
    if (mode == 1) {
        if (n < 1920) return n;
        if (n < 1952) return 1920 + rope_perm(n - 1920);
        if (n < 2048) return -1;
        return n - 96;
    }
    if (mode == 2) {
        const int h = n / 96, d = n % 96;
        return d < 64 ? n : h * 96 + 64 + rope_perm(d - 64);
    }
    if (mode == 3) {
        const int t = n >> 8, w = n & 255;
        return w < 128 ? 128 * t + w : FFH + 128 * t + (w - 128);
    }
    return n;
}
__device__ void transpose_w(const float* __restrict__ W, int K, int Nsrc, bf16_t* __restrict__ Wt, int Ndst, int mode, float* tile, int bid, int nb) {
    const int tid = threadIdx.x, nkt = K / 64, nnt = Ndst / 64;
    for (int t = bid; t < nkt * nnt; t += nb) {
        const int kt = t / nnt, nt = t % nnt;
        const int n = nt * 64 + (tid & 63), src = colmap(mode, n);
#pragma unroll 4
        for (int i = 0; i < 16; ++i) { const int kl = i * 4 + (tid >> 6); tile[kl * 65 + (tid & 63)] = src >= 0 ? W[(size_t)(kt * 64 + kl) * Nsrc + src] : 0.f; }
        __syncthreads();
#pragma unroll 4
        for (int i = 0; i < 16; ++i) { const int nl = i * 4 + (tid >> 6); Wt[(size_t)(nt * 64 + nl) * K + kt * 64 + (tid & 63)] = (bf16_t)f2bf(tile[(tid & 63) * 65 + nl]); }
        __syncthreads();
    }
}
__device__ void stage0(const Params& p, float* smem, int bid, int nb) {
    unsigned char* ws = p.ws;
    transpose_w(p.w_in, DM, 4000, (bf16_t*)(ws + WS_WIN), HP, 1, smem, bid, nb);
    transpose_w(p.w_uq, QLORA, MH * QK, (bf16_t*)(ws + WS_WUQ), MH * QK, 2, smem, bid, nb);
    transpose_w(p.w_ukv, KVLORA, 1024, (bf16_t*)(ws + WS_WUKV), 1024, 0, smem, bid, nb);
    transpose_w(p.w_bna, 512, DM, (bf16_t*)(ws + WS_WBNA), DM, 0, smem, bid, nb);
    transpose_w(p.w_bmla, 512, DM, (bf16_t*)(ws + WS_WBMLA), DM, 0, smem, bid, nb);
    transpose_w(p.w_out, DM, DM, (bf16_t*)(ws + WS_WOUT), DM, 0, smem, bid, nb);
    transpose_w(p.w_fi, DM, 2 * FFH, (bf16_t*)(ws + WS_WFI), 2 * FFH, 3, smem, bid, nb);
    transpose_w(p.w_fo, FFH, DM, (bf16_t*)(ws + WS_WFO), DM, 0, smem, bid, nb);
    const f32x4* xs = (const f32x4*)p.x; u32x4* xd = (u32x4*)(ws + WS_XB);
    for (size_t i = (size_t)bid * blockDim.x + threadIdx.x; i < (size_t)M * DM / 8; i += (size_t)nb * blockDim.x) {
        const f32x4 a = xs[2 * i], b = xs[2 * i + 1];
        xd[i] = (u32x4){pk2(a[0], a[1]), pk2(a[2], a[3]), pk2(b[0], b[1]), pk2(b[2], b[3])};
    }
    if (bid == 0) {
        float2* tab = (float2*)(ws + WS_ROPE);
        for (int e = threadIdx.x; e < 64 * 8; e += blockDim.x) {
            const int pos = e >> 3, i = e & 7;
            const float inv = __builtin_exp2f(-(float)i * 0.125f * 13.287712379549449f);
            const float rev = (float)pos * inv * 0.15915494309189535f;
            tab[e] = make_float2(__builtin_amdgcn_cosf(rev), __builtin_amdgcn_sinf(rev));
        }
    }
}

template <bool DUAL, class Epi>
__device__ __forceinline__ void gemm_v1(const bf16_t* __restrict__ A, int lda, const bf16_t* __restrict__ Bt, int K, int ntn, int btile_stride, int dual_off, const Epi& epi, int bid, int nb) {
    const int tid = threadIdx.x, lane = tid & 63, w = tid >> 6, wr = w >> 1, wc = w & 1, fr = lane & 15, fq = lane >> 4;
    const int ntm = M / 128;
    for (int t = bid; t < ntm * ntn; t += nb) {
        const int tm = t / ntn, tn = t % ntn;
        const int row0 = tm * 128 + wr * 64, col0 = tn * 128 + wc * 64, brow0 = tn * btile_stride + wc * 64;
        f32x4 acc[4][4], acc2[4][4];
#pragma unroll
        for (int i = 0; i < 4; ++i)
#pragma unroll
            for (int j = 0; j < 4; ++j) { acc[i][j] = (f32x4){0.f, 0.f, 0.f, 0.f}; acc2[i][j] = (f32x4){0.f, 0.f, 0.f, 0.f}; }
        const bf16_t* ap = A + (size_t)(row0 + fr) * lda + fq * 8;
        const bf16_t* bp = Bt + (size_t)(brow0 + fr) * K + fq * 8;
        for (int k = 0; k < K; k += 32) {
            bf16x8 a[4], b[4], b2[4];
#pragma unroll
            for (int i = 0; i < 4; ++i) a[i] = *(const bf16x8*)(ap + (size_t)i * 16 * lda + k);
#pragma unroll
            for (int j = 0; j < 4; ++j) b[j] = *(const bf16x8*)(bp + (size_t)j * 16 * K + k);
            if constexpr (DUAL) {
#pragma unroll
                for (int j = 0; j < 4; ++j) b2[j] = *(const bf16x8*)(bp + (size_t)(dual_off + j * 16) * K + k);
            }
#pragma unroll
            for (int i = 0; i < 4; ++i)
#pragma unroll
                for (int j = 0; j < 4; ++j) {
                    acc[i][j] = __builtin_amdgcn_mfma_f32_16x16x32_bf16(a[i], b[j], acc[i][j], 0, 0, 0);
                    if constexpr (DUAL) acc2[i][j] = __builtin_amdgcn_mfma_f32_16x16x32_bf16(a[i], b2[j], acc2[i][j], 0, 0, 0);
                }
        }
#pragma unroll
        for (int i = 0; i < 4; ++i)
#pragma unroll
            for (int j = 0; j < 4; ++j)
#pragma unroll
                for (int r = 0; r < 4; ++r) {
                    const int row = row0 + 16 * i + 4 * fq + r, col = col0 + 16 * j + fr;
                    if constexpr (DUAL) epi(row, col, acc[i][j][r], acc2[i][j][r]); else epi(row, col, acc[i][j][r]);
                }
    }
}

struct EpiH {
    bf16_t *qkv, *lat, *g;
    __device__ __forceinline__ void operator()(int row, int col, float v) const {
        const bf16_t b = (bf16_t)f2bf(v);
        if (col < 1536) qkv[(size_t)row * 1536 + col] = b;
        else if (col < 2048) lat[(size_t)row * 512 + (col - 1536)] = b;
        else g[(size_t)row * 2048 + (col - 2048)] = b;
    }
};
struct EpiQ {
    bf16_t* qm; const float2* tab;
    __device__ __forceinline__ void operator()(int row, int col, float v) const {
        const int d = col % 96;
        if (d >= 64) {
            const int pidx = d - 64, part = pidx >> 4, i = (pidx & 15) >> 1, odd = pidx & 1;
            const int t = row & (SEQ - 1), pos = part ? (t & 63) : (t >> 6);
            const float2 cs = tab[pos * 8 + i];
            const float partner = __shfl_xor(v, 1);
            v = v * cs.x + (odd ? partner : -partner) * cs.y;
        }
        qm[(size_t)row * 768 + col] = (bf16_t)f2bf(v * (0.10206207261596577f * LOG2E));
    }
};
struct EpiPlain { bf16_t* o; int ldc; __device__ __forceinline__ void operator()(int row, int col, float v) const { o[(size_t)row * ldc + col] = (bf16_t)f2bf(v); } };
struct EpiGateA {
    float* T; const bf16_t* g; const float* bg;
    __device__ __forceinline__ void operator()(int row, int col, float v) const { T[(size_t)row * DM + col] = sigmoidf_(bf2f(g[(size_t)row * 2048 + col]) + bg[col]) * v; }
};
struct EpiGateB {
    const float* T; const bf16_t* g; const float* bg; bf16_t* mg;
    __device__ __forceinline__ void operator()(int row, int col, float v) const {
        mg[(size_t)row * DM + col] = (bf16_t)f2bf(T[(size_t)row * DM + col] + sigmoidf_(bf2f(g[(size_t)row * 2048 + 1024 + col]) + bg[1024 + col]) * v);
    }
};
struct EpiRes {
    const float* base; float* y;
    __device__ __forceinline__ void operator()(int row, int col, float v) const { y[(size_t)row * DM + col] = DN_ALPHA * base[(size_t)row * DM + col] + v; }
};
struct EpiSwiglu {
    bf16_t* hid;
    __device__ __forceinline__ void operator()(int row, int col, float g, float u) const { hid[(size_t)row * FFH + col] = (bf16_t)f2bf(g * sigmoidf_(g) * u); }
};

__device__ void stage_lat(const Params& p, int bid, int nb) {
    const int lane = threadIdx.x & 63, gw = bid * (blockDim.x >> 6) + (threadIdx.x >> 6), ngw = nb * (blockDim.x >> 6);
    const bf16_t* lat = (const bf16_t*)(p.ws + WS_LAT); bf16_t* qln = (bf16_t*)(p.ws + WS_QLN); bf16_t* kvln = (bf16_t*)(p.ws + WS_KVLN); bf16_t* kpe = (bf16_t*)(p.ws + WS_KPE);
    const float2* tab = (const float2*)(p.ws + WS_ROPE);
    for (int row = gw; row < M; row += ngw) {
        const bf16_t* lr = lat + (size_t)row * 512;
        {
            const u32x2 v = *(const u32x2*)(lr + 4 * lane);
            const float a0 = bf2f(v.x & 0xffffu), a1 = bf2f(v.x >> 16), a2 = bf2f(v.y & 0xffffu), a3 = bf2f(v.y >> 16);
            const float rs = rsqrtf(wave_sum(a0 * a0 + a1 * a1 + a2 * a2 + a3 * a3) * (1.f / 256.f) + RMS_EPS);
            const f32x4 g = *(const f32x4*)(p.qn + 4 * lane);
            *(u32x2*)(qln + (size_t)row * 256 + 4 * lane) = (u32x2){pk2(a0 * rs * g[0], a1 * rs * g[1]), pk2(a2 * rs * g[2], a3 * rs * g[3])};
        }
        {
            const unsigned v = *(const unsigned*)(lr + 256 + 2 * lane);
            const float a0 = bf2f(v & 0xffffu), a1 = bf2f(v >> 16);
            const float rs = rsqrtf(wave_sum(a0 * a0 + a1 * a1) * (1.f / 128.f) + RMS_EPS);
            *(unsigned*)(kvln + (size_t)row * 128 + 2 * lane) = pk2(a0 * rs * p.kvn[2 * lane], a1 * rs * p.kvn[2 * lane + 1]);
        }
        {
            const int pidx = lane & 31, part = pidx >> 4, i = (pidx & 15) >> 1, odd = pidx & 1;
            const float v = bf2f(lr[384 + pidx]);
            const int t = row & (SEQ - 1), pos = part ? (t & 63) : (t >> 6);
            const float2 cs = tab[pos * 8 + i];
            const float partner = __shfl_xor(v, 1);
            const float o = v * cs.x + (odd ? partner : -partner) * cs.y;
            if (lane < 32) kpe[(size_t)row * 32 + pidx] = (bf16_t)f2bf(o);
        }
    }
}

__device__ void stage_na(const Params& p, int bid, int nb) {
    const bf16_t* qkv = (const bf16_t*)(p.ws + WS_QKV); bf16_t* ao = (bf16_t*)(p.ws + WS_AO);
    for (int idx = bid * blockDim.x + threadIdx.x; idx < M * NAH; idx += nb * blockDim.x) {
        const int token = idx % M, h = idx / M;
        const int b = token / SEQ, t = token % SEQ, r = t / GRIDW, c = t % GRIDW;
        int rs = r - 4; rs = rs < 0 ? 0 : (rs > 56 ? 56 : rs);
        int cs = c - 8; cs = cs < 0 ? 0 : (cs > 48 ? 48 : cs);
        float q[64], o[64];
        const bf16_t* qp = qkv + (size_t)token * 1536 + h * 64;
#pragma unroll
        for (int d8 = 0; d8 < 8; ++d8) { const u32x4 v = *(const u32x4*)(qp + 8 * d8);
#pragma unroll
            for (int e = 0; e < 4; ++e) { q[8 * d8 + 2 * e] = bf2f(v[e] & 0xffffu) * (0.125f * LOG2E); q[8 * d8 + 2 * e + 1] = bf2f(v[e] >> 16) * (0.125f * LOG2E); } }
#pragma unroll
        for (int d = 0; d < 64; ++d) o[d] = 0.f;
        float m = -INFINITY, l = 0.f;
        for (int i = 0; i < 8; ++i)
            for (int j = 0; j < 16; ++j) {
                const size_t kt = (size_t)b * SEQ + (rs + i) * GRIDW + cs + j;
                const bf16_t* kp = qkv + kt * 1536 + 512 + h * 64; const bf16_t* vp = kp + 512;
                float s = 0.f;
#pragma unroll
                for (int d8 = 0; d8 < 8; ++d8) { const u32x4 v = *(const u32x4*)(kp + 8 * d8);
#pragma unroll
                    for (int e = 0; e < 4; ++e) { s += q[8 * d8 + 2 * e] * bf2f(v[e] & 0xffffu); s += q[8 * d8 + 2 * e + 1] * bf2f(v[e] >> 16); } }
                s += p.rpb[(h * 15 + (rs + i - r + 7)) * 31 + (cs + j - c + 15)] * LOG2E;
                const float mn = fmaxf(m, s), alpha = __builtin_exp2f(m - mn), pe = __builtin_exp2f(s - mn);
                l = l * alpha + pe; m = mn;
#pragma unroll
                for (int d8 = 0; d8 < 8; ++d8) { const u32x4 v = *(const u32x4*)(vp + 8 * d8);
#pragma unroll
                    for (int e = 0; e < 4; ++e) { o[8 * d8 + 2 * e] = o[8 * d8 + 2 * e] * alpha + pe * bf2f(v[e] & 0xffffu); o[8 * d8 + 2 * e + 1] = o[8 * d8 + 2 * e + 1] * alpha + pe * bf2f(v[e] >> 16); } }
            }
        const float il = 1.f / l;
        bf16_t* op = ao + (size_t)token * 1024 + h * 64;
#pragma unroll
        for (int d8 = 0; d8 < 8; ++d8) *(u32x4*)(op + 8 * d8) = (u32x4){pk2(o[8 * d8] * il, o[8 * d8 + 1] * il), pk2(o[8 * d8 + 2] * il, o[8 * d8 + 3] * il), pk2(o[8 * d8 + 4] * il, o[8 * d8 + 5] * il), pk2(o[8 * d8 + 6] * il, o[8 * d8 + 7] * il)};
    }
}

__device__ void stage_mla(const Params& p, float* smem, int bid, int nb) {
    const bf16_t* qm = (const bf16_t*)(p.ws + WS_QM); const bf16_t* kvm = (const bf16_t*)(p.ws + WS_KVM); const bf16_t* kpe = (const bf16_t*)(p.ws + WS_KPE); bf16_t* ao = (bf16_t*)(p.ws + WS_AO);
    float* Kf = smem; float* Vf = smem + 64 * 96;
    const int tid = threadIdx.x;
    for (int unit = bid; unit < 4 * 8 * 16; unit += nb) {
        const int b = unit / 128, h = (unit / 16) % 8, qb = unit % 16;
        const size_t token = (size_t)b * SEQ + qb * 256 + tid;
        float q[96], o[64];
        const bf16_t* qp = qm + token * 768 + h * 96;
#pragma unroll
        for (int d8 = 0; d8 < 12; ++d8) { const u32x4 v = *(const u32x4*)(qp + 8 * d8);
#pragma unroll
            for (int e = 0; e < 4; ++e) { q[8 * d8 + 2 * e] = bf2f(v[e] & 0xffffu); q[8 * d8 + 2 * e + 1] = bf2f(v[e] >> 16); } }
#pragma unroll
        for (int d = 0; d < 64; ++d) o[d] = 0.f;
        float m = -INFINITY, l = 0.f;
        for (int kt = 0; kt < SEQ / 64; ++kt) {
            __syncthreads();
            const size_t k0 = (size_t)b * SEQ + kt * 64;
            for (int e = tid; e < 64 * 96; e += 256) { const int key = e / 96, d = e % 96;
                Kf[e] = d < 64 ? bf2f(kvm[(k0 + key) * 1024 + h * 128 + d]) : bf2f(kpe[(k0 + key) * 32 + (d - 64)]); }
            for (int e = tid; e < 64 * 64; e += 256) { const int key = e >> 6, d = e & 63; Vf[e] = bf2f(kvm[(k0 + key) * 1024 + h * 128 + 64 + d]); }
            __syncthreads();
            for (int key = 0; key < 64; key += 4) {
                float s[4];
#pragma unroll
                for (int c = 0; c < 4; ++c) { float a = 0.f; const f32x4* kr = (const f32x4*)(Kf + (key + c) * 96);
#pragma unroll
                    for (int d4 = 0; d4 < 24; ++d4) { const f32x4 kv = kr[d4]; a += q[4 * d4] * kv[0]; a += q[4 * d4 + 1] * kv[1]; a += q[4 * d4 + 2] * kv[2]; a += q[4 * d4 + 3] * kv[3]; }
                    s[c] = a; }
                const float mn = fmaxf(fmaxf(fmaxf(s[0], s[1]), fmaxf(s[2], s[3])), m);
                const float alpha = __builtin_exp2f(m - mn);
                float pe[4];
#pragma unroll
                for (int c = 0; c < 4; ++c) pe[c] = __builtin_exp2f(s[c] - mn);
                l = l * alpha + (pe[0] + pe[1]) + (pe[2] + pe[3]); m = mn;
#pragma unroll
                for (int d4 = 0; d4 < 16; ++d4) {
                    f32x4 a = (f32x4){o[4 * d4], o[4 * d4 + 1], o[4 * d4 + 2], o[4 * d4 + 3]} * alpha;
#pragma unroll
                    for (int c = 0; c < 4; ++c) a += pe[c] * ((const f32x4*)(Vf + (key + c) * 64))[d4];
                    o[4 * d4] = a[0]; o[4 * d4 + 1] = a[1]; o[4 * d4 + 2] = a[2]; o[4 * d4 + 3] = a[3];
                }
            }
        }
        const float il = 1.f / l;
        bf16_t* op = ao + token * 1024 + 512 + h * 64;
#pragma unroll
        for (int d8 = 0; d8 < 8; ++d8) *(u32x4*)(op + 8 * d8) = (u32x4){pk2(o[8 * d8] * il, o[8 * d8 + 1] * il), pk2(o[8 * d8 + 2] * il, o[8 * d8 + 3] * il), pk2(o[8 * d8 + 4] * il, o[8 * d8 + 5] * il), pk2(o[8 * d8 + 6] * il, o[8 * d8 + 7] * il)};
    }
}

__device__ void stage_ln(float* y, const float* __restrict__ g, const float* __restrict__ bta, bf16_t* ob, int bid, int nb) {
    const int lane = threadIdx.x & 63, gw = bid * (blockDim.x >> 6) + (threadIdx.x >> 6), ngw = nb * (blockDim.x >> 6);
    for (int row = gw; row < M; row += ngw) {
        f32x4* yr = (f32x4*)(y + (size_t)row * DM) + lane;
        f32x4 v[4]; float s = 0.f;
#pragma unroll
        for (int j = 0; j < 4; ++j) { v[j] = yr[64 * j]; s += (v[j][0] + v[j][1]) + (v[j][2] + v[j][3]); }
        const float mean = wave_sum(s) * (1.f / DM); float s2 = 0.f;
#pragma unroll
        for (int j = 0; j < 4; ++j) { v[j] = v[j] - mean; s2 += (v[j][0] * v[j][0] + v[j][1] * v[j][1]) + (v[j][2] * v[j][2] + v[j][3] * v[j][3]); }
        const float rstd = rsqrtf(wave_sum(s2) * (1.f / DM) + LN_EPS);
#pragma unroll
        for (int j = 0; j < 4; ++j) {
            const f32x4 gg = ((const f32x4*)g)[lane + 64 * j], bb = ((const f32x4*)bta)[lane + 64 * j];
            const f32x4 o = v[j] * rstd * gg + bb;
            yr[64 * j] = o;
            if (ob) *(u32x2*)(ob + (size_t)row * DM + 4 * (lane + 64 * j)) = (u32x2){pk2(o[0], o[1]), pk2(o[2], o[3])};
        }
    }
}

constexpr int NPHASE = 12;
__device__ __forceinline__ void run_phase(int ph, const Params& p, float* smem, int bid, int nb) {
    unsigned char* ws = p.ws;
    switch (ph) {
    case 0: stage0(p, smem, bid, nb); break;
    case 1: { EpiH e{(bf16_t*)(ws + WS_QKV), (bf16_t*)(ws + WS_LAT), (bf16_t*)(ws + WS_G)};
              gemm_v1<false>((const bf16_t*)(ws + WS_XB), DM, (const bf16_t*)(ws + WS_WIN), DM, HP / 128, 128, 0, e, bid, nb); } break;
    case 2: stage_lat(p, bid, nb); break;
    case 3: { EpiQ e{(bf16_t*)(ws + WS_QM), (const float2*)(ws + WS_ROPE)};
              gemm_v1<false>((const bf16_t*)(ws + WS_QLN), QLORA, (const bf16_t*)(ws + WS_WUQ), QLORA, 768 / 128, 128, 0, e, bid, nb);
              EpiPlain e2{(bf16_t*)(ws + WS_KVM), 1024};
              gemm_v1<false>((const bf16_t*)(ws + WS_KVLN), KVLORA, (const bf16_t*)(ws + WS_WUKV), KVLORA, 1024 / 128, 128, 0, e2, bid, nb); } break;
    case 4: stage_na(p, bid, nb); stage_mla(p, smem, bid, nb); break;
    case 5: { EpiGateA e{p.out, (const bf16_t*)(ws + WS_G), p.b_gate};
              gemm_v1<false>((const bf16_t*)(ws + WS_AO), 1024, (const bf16_t*)(ws + WS_WBNA), 512, DM / 128, 128, 0, e, bid, nb); } break;
    case 6: { EpiGateB e{p.out, (const bf16_t*)(ws + WS_G), p.b_gate, (bf16_t*)(ws + WS_MG)};
              gemm_v1<false>((const bf16_t*)(ws + WS_AO) + 512, 1024, (const bf16_t*)(ws + WS_WBMLA), 512, DM / 128, 128, 0, e, bid, nb); } break;
    case 7: { EpiRes e{p.x, p.out};
              gemm_v1<false>((const bf16_t*)(ws + WS_MG), DM, (const bf16_t*)(ws + WS_WOUT), DM, DM / 128, 128, 0, e, bid, nb); } break;
    case 8: stage_ln(p.out, p.ln1g, p.ln1b, (bf16_t*)(ws + WS_X1B), bid, nb); break;
    case 9: { EpiSwiglu e{(bf16_t*)(ws + WS_HID)};
              gemm_v1<true>((const bf16_t*)(ws + WS_X1B), DM, (const bf16_t*)(ws + WS_WFI), DM, FFH / 128, 256, 128, e, bid, nb); } break;
    case 10: { EpiRes e{p.out, p.out};
               gemm_v1<false>((const bf16_t*)(ws + WS_HID), FFH, (const bf16_t*)(ws + WS_WFO), FFH, DM / 128, 128, 0, e, bid, nb); } break;
    case 11: stage_ln(p.out, p.ln2g, p.ln2b, nullptr, bid, nb); break;
    }
}

constexpr int SMEM_FLOATS = 64 * 96 + 64 * 64;
#if FUSED
__global__ void __launch_bounds__(256) fwd_megakernel(Params p) {
    __shared__ __attribute__((aligned(16))) float smem[SMEM_FLOATS];
    cg::grid_group grid = cg::this_grid();
    for (int ph = 0; ph < NPHASE; ++ph) {
        run_phase(ph, p, smem, blockIdx.x, gridDim.x);
        if (ph + 1 < NPHASE) grid.sync();
    }
}
#else
template <int PH> __global__ void __launch_bounds__(256) phase_kernel(Params p) {
    __shared__ __attribute__((aligned(16))) float smem[SMEM_FLOATS];
    run_phase(PH, p, smem, blockIdx.x, gridDim.x);
}
template <int PH> static void launch_phase(const Params& p, hipStream_t stream) {
    hipLaunchKernelGGL(phase_kernel<PH>, dim3(1024), dim3(256), 0, stream, p);
    if constexpr (PH + 1 < NPHASE) launch_phase<PH + 1>(p, stream);
}
#endif

extern "C" void kernel_launch(void* const* d_in, const int* in_sizes, int n_in, void* d_out, int out_size, void* d_ws, size_t ws_size, hipStream_t stream) {
    if (n_in != 17 || out_size != M * DM || ws_size < WS_END) { fprintf(stderr, "kernel_launch: unexpected shapes (n_in %d, out %d, ws %zu)\n", n_in, out_size, ws_size); return; }
    Params p{};
    p.x = (const float*)d_in[0]; p.w_in = (const float*)d_in[1]; p.b_gate = (const float*)d_in[2]; p.rpb = (const float*)d_in[3]; p.qn = (const float*)d_in[4];
    p.w_uq = (const float*)d_in[5]; p.kvn = (const float*)d_in[6]; p.w_ukv = (const float*)d_in[7]; p.w_bna = (const float*)d_in[8]; p.w_bmla = (const float*)d_in[9];
    p.w_out = (const float*)d_in[10]; p.ln1g = (const float*)d_in[11]; p.ln1b = (const float*)d_in[12]; p.w_fi = (const float*)d_in[13]; p.w_fo = (const float*)d_in[14];
    p.ln2g = (const float*)d_in[15]; p.ln2b = (const float*)d_in[16];
    p.out = (float*)d_out; p.ws = (unsigned char*)d_ws;
#if FUSED
    static int grid_blocks = 0;
    if (!grid_blocks) {
        int dev = 0, cus = 0, per_cu = 0;
        hipGetDevice(&dev);
        hipDeviceGetAttribute(&cus, hipDeviceAttributeMultiprocessorCount, dev);
        hipOccupancyMaxActiveBlocksPerMultiprocessor(&per_cu, fwd_megakernel, 256, 0);
        if (per_cu < 1) per_cu = 1;
        grid_blocks = cus * per_cu;
    }
    void* args[] = {&p};
    hipError_t e = hipLaunchCooperativeKernel((void*)fwd_megakernel, dim3(grid_blocks), dim3(256), args, 0, stream);
    if (e != hipSuccess) fprintf(stderr, "cooperative launch failed: %s (grid %d)\n", hipGetErrorString(e), grid_blocks);
#else
    launch_phase<0>(p, stream);
#endif
}
```

```cpp
#include <hip/hip_runtime.h>
#include <hip/hip_cooperative_groups.h>
#include <cstdint>
#include <cstdio>
namespace cg = cooperative_groups;

#ifndef FUSED
#define FUSED 1
#endif

typedef unsigned short bf16_t;
typedef short bf16x8 __attribute__((ext_vector_type(8)));
typedef float f32x4 __attribute__((ext_vector_type(4)));
typedef unsigned u32x4 __attribute__((ext_vector_type(4)));
typedef unsigned u32x2 __attribute__((ext_vector_type(2)));

constexpr int M = 16384, DM = 1024, SEQ = 4096, GRIDW = 64;
constexpr int NAH = 8, NAD = 64;
constexpr int QLORA = 256, KVLORA = 128, ROPE = 32, NOPE = 64, QK = 96, VD = 64, MH = 8;
constexpr int FFH = 2816;
constexpr int HP = 4096;
constexpr float LOG2E = 1.4426950408889634f;
constexpr float DN_ALPHA = 1.189207115002721f;
constexpr float LN_EPS = 1e-5f, RMS_EPS = 1e-6f;

constexpr size_t MiB = 1u << 20;
constexpr size_t WS_CTL = 0;
constexpr size_t WS_ROPE = 64 * 1024;
constexpr size_t WS_WIN = 1 * MiB;
constexpr size_t WS_WUQ = 9 * MiB;
constexpr size_t WS_WUKV = 9 * MiB + 512 * 1024;
constexpr size_t WS_WBNA = 10 * MiB;
constexpr size_t WS_WBMLA = 11 * MiB;
constexpr size_t WS_WOUT = 12 * MiB;
constexpr size_t WS_WFI = 14 * MiB;
constexpr size_t WS_WFO = 25 * MiB;
constexpr size_t WS_XB = 32 * MiB;
constexpr size_t WS_QM = 32 * MiB;
constexpr size_t WS_KPE = 56 * MiB;
constexpr size_t WS_MG = 32 * MiB;
constexpr size_t WS_QKV = 64 * MiB;
constexpr size_t WS_X1B = 64 * MiB;
constexpr size_t WS_LAT = 112 * MiB;
constexpr size_t WS_G = 128 * MiB;
constexpr size_t WS_HID = 128 * MiB;
constexpr size_t WS_KVM = 192 * MiB;
constexpr size_t WS_QLN = 224 * MiB;
constexpr size_t WS_KVLN = 232 * MiB;
constexpr size_t WS_AO = 224 * MiB;
constexpr size_t WS_END = 256 * MiB;

struct Params {
    const float *x, *w_in, *b_gate, *rpb, *qn, *w_uq, *kvn, *w_ukv, *w_bna, *w_bmla, *w_out, *ln1g, *ln1b, *w_fi, *w_fo, *ln2g, *ln2b;
    float* out; unsigned char* ws;
};

__device__ __forceinline__ unsigned f2bf(float f) { unsigned u = __builtin_bit_cast(unsigned, f); return (u + 0x7fffu + ((u >> 16) & 1u)) >> 16; }
__device__ __forceinline__ float bf2f(unsigned b) { return __builtin_bit_cast(float, b << 16); }
__device__ __forceinline__ unsigned pk2(float lo, float hi) { return f2bf(lo) | (f2bf(hi) << 16); }
__device__ __forceinline__ float wave_sum(float v) {
#pragma unroll
    for (int o = 1; o < 64; o <<= 1) v += __shfl_xor(v, o);
    return v;
}
__device__ __forceinline__ float sigmoidf_(float z) { return 1.f / (1.f + __expf(-z)); }
__device__ __forceinline__ int rope_perm(int p) { return (p >> 4) * 16 + (p & 1) * 8 + ((p & 15) >> 1); }

__device__ __forceinline__ int colmap(int mode, int n) {
    if (mode == 1) {
        if (n < 1920) return n;
        if (n < 1952) return 1920 + rope_perm(n - 1920);
        if (n < 2048) return -1;
        return n - 96;
    }
    if (mode == 2) {
        const int h = n / 96, d = n % 96;
        return d < 64 ? n : h * 96 + 64 + rope_perm(d - 64);
    }
    if (mode == 3) {
        const int t = n >> 8, w = n & 255;
        return w < 128 ? 128 * t + w : FFH + 128 * t + (w - 128);
    }
    return n;
}
__device__ void transpose_w(const float* __restrict__ W, int K, int Nsrc, bf16_t* __restrict__ Wt, int Ndst, int mode, float* tile, int bid, int nb) {
    const int tid = threadIdx.x, nkt = K / 64, nnt = Ndst / 64;
    for (int t = bid; t < nkt * nnt; t += nb) {
        const int kt = t / nnt, nt = t % nnt;
        const int n = nt * 64 + (tid & 63), src = colmap(mode, n);
#pragma unroll 4
        for (int i = 0; i < 16; ++i) { const int kl = i * 4 + (tid >> 6); tile[kl * 65 + (tid & 63)] = src >= 0 ? W[(size_t)(kt * 64 + kl) * Nsrc + src] : 0.f; }
        __syncthreads();
#pragma unroll 4
        for (int i = 0; i < 16; ++i) { const int nl = i * 4 + (tid >> 6); Wt[(size_t)(nt * 64 + nl) * K + kt * 64 + (tid & 63)] = (bf16_t)f2bf(tile[(tid & 63) * 65 + nl]); }
        __syncthreads();
    }
}
__device__ void stage0(const Params& p, float* smem, int bid, int nb) {
    unsigned char* ws = p.ws;
    transpose_w(p.w_in, DM, 4000, (bf16_t*)(ws + WS_WIN), HP, 1, smem, bid, nb);
    transpose_w(p.w_uq, QLORA, MH * QK, (bf16_t*)(ws + WS_WUQ), MH * QK, 2, smem, bid, nb);
    transpose_w(p.w_ukv, KVLORA, 1024, (bf16_t*)(ws + WS_WUKV), 1024, 0, smem, bid, nb);
    transpose_w(p.w_bna, 512, DM, (bf16_t*)(ws + WS_WBNA), DM, 0, smem, bid, nb);
    transpose_w(p.w_bmla, 512, DM, (bf16_t*)(ws + WS_WBMLA), DM, 0, smem, bid, nb);
    transpose_w(p.w_out, DM, DM, (bf16_t*)(ws + WS_WOUT), DM, 0, smem, bid, nb);
    transpose_w(p.w_fi, DM, 2 * FFH, (bf16_t*)(ws + WS_WFI), 2 * FFH, 3, smem, bid, nb);
    transpose_w(p.w_fo, FFH, DM, (bf16_t*)(ws + WS_WFO), DM, 0, smem, bid, nb);
    const f32x4* xs = (const f32x4*)p.x; u32x4* xd = (u32x4*)(ws + WS_XB);
    for (size_t i = (size_t)bid * blockDim.x + threadIdx.x; i < (size_t)M * DM / 8; i += (size_t)nb * blockDim.x) {
        const f32x4 a = xs[2 * i], b = xs[2 * i + 1];
        xd[i] = (u32x4){pk2(a[0], a[1]), pk2(a[2], a[3]), pk2(b[0], b[1]), pk2(b[2], b[3])};
    }
    if (bid == 0) {
        float2* tab = (float2*)(ws + WS_ROPE);
        for (int e = threadIdx.x; e < 64 * 8; e += blockDim.x) {
            const int pos = e >> 3, i = e & 7;
            const float inv = __builtin_exp2f(-(float)i * 0.125f * 13.287712379549449f);
            const float rev = (float)pos * inv * 0.15915494309189535f;
            tab[e] = make_float2(__builtin_amdgcn_cosf(rev), __builtin_amdgcn_sinf(rev));
        }
    }
}

template <bool DUAL, class Epi>
__device__ __forceinline__ void gemm_v1(const bf16_t* __restrict__ A, int lda, const bf16_t* __restrict__ Bt, int K, int ntn, int btile_stride, int dual_off, const Epi& epi, int bid, int nb) {
    const int tid = threadIdx.x, lane = tid & 63, w = tid >> 6, wr = w >> 1, wc = w & 1, fr = lane & 15, fq = lane >> 4;
    const int ntm = M / 128;
    for (int t = bid; t < ntm * ntn; t += nb) {
        const int tm = t / ntn, tn = t % ntn;
        const int row0 = tm * 128 + wr * 64, col0 = tn * 128 + wc * 64, brow0 = tn * btile_stride + wc * 64;
        f32x4 acc[4][4], acc2[4][4];
#pragma unroll
        for (int i = 0; i < 4; ++i)
#pragma unroll
            for (int j = 0; j < 4; ++j) { acc[i][j] = (f32x4){0.f, 0.f, 0.f, 0.f}; acc2[i][j] = (f32x4){0.f, 0.f, 0.f, 0.f}; }
        const bf16_t* ap = A + (size_t)(row0 + fr) * lda + fq * 8;
        const bf16_t* bp = Bt + (size_t)(brow0 + fr) * K + fq * 8;
        for (int k = 0; k < K; k += 32) {
            bf16x8 a[4], b[4], b2[4];
#pragma unroll
            for (int i = 0; i < 4; ++i) a[i] = *(const bf16x8*)(ap + (size_t)i * 16 * lda + k);
#pragma unroll
            for (int j = 0; j < 4; ++j) b[j] = *(const bf16x8*)(bp + (size_t)j * 16 * K + k);
            if constexpr (DUAL) {
#pragma unroll
                for (int j = 0; j < 4; ++j) b2[j] = *(const bf16x8*)(bp + (size_t)(dual_off + j * 16) * K + k);
            }
#pragma unroll
            for (int i = 0; i < 4; ++i)
#pragma unroll
                for (int j = 0; j < 4; ++j) {
                    acc[i][j] = __builtin_amdgcn_mfma_f32_16x16x32_bf16(a[i], b[j], acc[i][j], 0, 0, 0);
                    if constexpr (DUAL) acc2[i][j] = __builtin_amdgcn_mfma_f32_16x16x32_bf16(a[i], b2[j], acc2[i][j], 0, 0, 0);
                }
        }
#pragma unroll
        for (int i = 0; i < 4; ++i)
#pragma unroll
            for (int j = 0; j < 4; ++j)
#pragma unroll
                for (int r = 0; r < 4; ++r) {
                    const int row = row0 + 16 * i + 4 * fq + r, col = col0 + 16 * j + fr;
                    if constexpr (DUAL) epi(row, col, acc[i][j][r], acc2[i][j][r]); else epi(row, col, acc[i][j][r]);
                }
    }
}

struct EpiH {
    bf16_t *qkv, *lat, *g;
    __device__ __forceinline__ void operator()(int row, int col, float v) const {
        const bf16_t b = (bf16_t)f2bf(v);
        if (col < 1536) qkv[(size_t)row * 1536 + col] = b;
        else if (col < 2048) lat[(size_t)row * 512 + (col - 1536)] = b;
        else g[(size_t)row * 2048 + (col - 2048)] = b;
    }
};
struct EpiQ {
    bf16_t* qm; const float2* tab;
    __device__ __forceinline__ void operator()(int row, int col, float v) const {
        const int d = col % 96;
        if (d >= 64) {
            const int pidx = d - 64, part = pidx >> 4, i = (pidx & 15) >> 1, odd = pidx & 1;
            const int t = row & (SEQ - 1), pos = part ? (t & 63) : (t >> 6);
            const float2 cs = tab[pos * 8 + i];
            const float partner = __shfl_xor(v, 1);
            v = v * cs.x + (odd ? partner : -partner) * cs.y;
        }
        qm[(size_t)row * 768 + col] = (bf16_t)f2bf(v * (0.10206207261596577f * LOG2E));
    }
};
struct EpiPlain { bf16_t* o; int ldc; __device__ __forceinline__ void operator()(int row, int col, float v) const { o[(size_t)row * ldc + col] = (bf16_t)f2bf(v); } };
struct EpiGateA {
    float* T; const bf16_t* g; const float* bg;
    __device__ __forceinline__ void operator()(int row, int col, float v) const { T[(size_t)row * DM + col] = sigmoidf_(bf2f(g[(size_t)row * 2048 + col]) + bg[col]) * v; }
};
struct EpiGateB {
    const float* T; const bf16_t* g; const float* bg; bf16_t* mg;
    __device__ __forceinline__ void operator()(int row, int col, float v) const {
        mg[(size_t)row * DM + col] = (bf16_t)f2bf(T[(size_t)row * DM + col] + sigmoidf_(bf2f(g[(size_t)row * 2048 + 1024 + col]) + bg[1024 + col]) * v);
    }
};
struct EpiRes {
    const float* base; float* y;
    __device__ __forceinline__ void operator()(int row, int col, float v) const { y[(size_t)row * DM + col] = DN_ALPHA * base[(size_t)row * DM + col] + v; }
};
struct EpiSwiglu {
    bf16_t* hid;
    __device__ __forceinline__ void operator()(int row, int col, float g, float u) const { hid[(size_t)row * FFH + col] = (bf16_t)f2bf(g * sigmoidf_(g) * u); }
};

__device__ void stage_lat(const Params& p, int bid, int nb) {
    const int lane = threadIdx.x & 63, gw = bid * (blockDim.x >> 6) + (threadIdx.x >> 6), ngw = nb * (blockDim.x >> 6);
    const bf16_t* lat = (const bf16_t*)(p.ws + WS_LAT); bf16_t* qln = (bf16_t*)(p.ws + WS_QLN); bf16_t* kvln = (bf16_t*)(p.ws + WS_KVLN); bf16_t* kpe = (bf16_t*)(p.ws + WS_KPE);
    const float2* tab = (const float2*)(p.ws + WS_ROPE);
    for (int row = gw; row < M; row += ngw) {
        const bf16_t* lr = lat + (size_t)row * 512;
        {
            const u32x2 v = *(const u32x2*)(lr + 4 * lane);
            const float a0 = bf2f(v.x & 0xffffu), a1 = bf2f(v.x >> 16), a2 = bf2f(v.y & 0xffffu), a3 = bf2f(v.y >> 16);
            const float rs = rsqrtf(wave_sum(a0 * a0 + a1 * a1 + a2 * a2 + a3 * a3) * (1.f / 256.f) + RMS_EPS);
            const f32x4 g = *(const f32x4*)(p.qn + 4 * lane);
            *(u32x2*)(qln + (size_t)row * 256 + 4 * lane) = (u32x2){pk2(a0 * rs * g[0], a1 * rs * g[1]), pk2(a2 * rs * g[2], a3 * rs * g[3])};
        }
        {
            const unsigned v = *(const unsigned*)(lr + 256 + 2 * lane);
            const float a0 = bf2f(v & 0xffffu), a1 = bf2f(v >> 16);
            const float rs = rsqrtf(wave_sum(a0 * a0 + a1 * a1) * (1.f / 128.f) + RMS_EPS);
            *(unsigned*)(kvln + (size_t)row * 128 + 2 * lane) = pk2(a0 * rs * p.kvn[2 * lane], a1 * rs * p.kvn[2 * lane + 1]);
        }
        {
            const int pidx = lane & 31, part = pidx >> 4, i = (pidx & 15) >> 1, odd = pidx & 1;
            const float v = bf2f(lr[384 + pidx]);
            const int t = row & (SEQ - 1), pos = part ? (t & 63) : (t >> 6);
            const float2 cs = tab[pos * 8 + i];
            const float partner = __shfl_xor(v, 1);
            const float o = v * cs.x + (odd ? partner : -partner) * cs.y;
            if (lane < 32) kpe[(size_t)row * 32 + pidx] = (bf16_t)f2bf(o);
        }
    }
}

__device__ void stage_na(const Params& p, int bid, int nb) {
    const bf16_t* qkv = (const bf16_t*)(p.ws + WS_QKV); bf16_t* ao = (bf16_t*)(p.ws + WS_AO);
    for (int idx = bid * blockDim.x + threadIdx.x; idx < M * NAH; idx += nb * blockDim.x) {
        const int token = idx % M, h = idx / M;
        const int b = token / SEQ, t = token % SEQ, r = t / GRIDW, c = t % GRIDW;
        int rs = r - 4; rs = rs < 0 ? 0 : (rs > 56 ? 56 : rs);
        int cs = c - 8; cs = cs < 0 ? 0 : (cs > 48 ? 48 : cs);
        float q[64], o[64];
        const bf16_t* qp = qkv + (size_t)token * 1536 + h * 64;
#pragma unroll
        for (int d8 = 0; d8 < 8; ++d8) { const u32x4 v = *(const u32x4*)(qp + 8 * d8);
#pragma unroll
            for (int e = 0; e < 4; ++e) { q[8 * d8 + 2 * e] = bf2f(v[e] & 0xffffu) * (0.125f * LOG2E); q[8 * d8 + 2 * e + 1] = bf2f(v[e] >> 16) * (0.125f * LOG2E); } }
#pragma unroll
        for (int d = 0; d < 64; ++d) o[d] = 0.f;
        float m = -INFINITY, l = 0.f;
        for (int i = 0; i < 8; ++i)
            for (int j = 0; j < 16; ++j) {
                const size_t kt = (size_t)b * SEQ + (rs + i) * GRIDW + cs + j;
                const bf16_t* kp = qkv + kt * 1536 + 512 + h * 64; const bf16_t* vp = kp + 512;
                float s = 0.f;
#pragma unroll
                for (int d8 = 0; d8 < 8; ++d8) { const u32x4 v = *(const u32x4*)(kp + 8 * d8);
#pragma unroll
                    for (int e = 0; e < 4; ++e) { s += q[8 * d8 + 2 * e] * bf2f(v[e] & 0xffffu); s += q[8 * d8 + 2 * e + 1] * bf2f(v[e] >> 16); } }
                s += p.rpb[(h * 15 + (rs + i - r + 7)) * 31 + (cs + j - c + 15)] * LOG2E;
                const float mn = fmaxf(m, s), alpha = __builtin_exp2f(m - mn), pe = __builtin_exp2f(s - mn);
                l = l * alpha + pe; m = mn;
#pragma unroll
                for (int d8 = 0; d8 < 8; ++d8) { const u32x4 v = *(const u32x4*)(vp + 8 * d8);
#pragma unroll
                    for (int e = 0; e < 4; ++e) { o[8 * d8 + 2 * e] = o[8 * d8 + 2 * e] * alpha + pe * bf2f(v[e] & 0xffffu); o[8 * d8 + 2 * e + 1] = o[8 * d8 + 2 * e + 1] * alpha + pe * bf2f(v[e] >> 16); } }
            }
        const float il = 1.f / l;
        bf16_t* op = ao + (size_t)token * 1024 + h * 64;
#pragma unroll
        for (int d8 = 0; d8 < 8; ++d8) *(u32x4*)(op + 8 * d8) = (u32x4){pk2(o[8 * d8] * il, o[8 * d8 + 1] * il), pk2(o[8 * d8 + 2] * il, o[8 * d8 + 3] * il), pk2(o[8 * d8 + 4] * il, o[8 * d8 + 5] * il), pk2(o[8 * d8 + 6] * il, o[8 * d8 + 7] * il)};
    }
}

__device__ void stage_mla(const Params& p, float* smem, int bid, int nb) {
    const bf16_t* qm = (const bf16_t*)(p.ws + WS_QM); const bf16_t* kvm = (const bf16_t*)(p.ws + WS_KVM); const bf16_t* kpe = (const bf16_t*)(p.ws + WS_KPE); bf16_t* ao = (bf16_t*)(p.ws + WS_AO);
    float* Kf = smem; float* Vf = smem + 64 * 96;
    const int tid = threadIdx.x;
    for (int unit = bid; unit < 4 * 8 * 16; unit += nb) {
        const int b = unit / 128, h = (unit / 16) % 8, qb = unit % 16;
        const size_t token = (size_t)b * SEQ + qb * 256 + tid;
        float q[96], o[64];
        const bf16_t* qp = qm + token * 768 + h * 96;
#pragma unroll
        for (int d8 = 0; d8 < 12; ++d8) { const u32x4 v = *(const u32x4*)(qp + 8 * d8);
#pragma unroll
            for (int e = 0; e < 4; ++e) { q[8 * d8 + 2 * e] = bf2f(v[e] & 0xffffu); q[8 * d8 + 2 * e + 1] = bf2f(v[e] >> 16); } }
#pragma unroll
        for (int d = 0; d < 64; ++d) o[d] = 0.f;
        float m = -INFINITY, l = 0.f;
        for (int kt = 0; kt < SEQ / 64; ++kt) {
            __syncthreads();
            const size_t k0 = (size_t)b * SEQ + kt * 64;
            for (int e = tid; e < 64 * 96; e += 256) { const int key = e / 96, d = e % 96;
                Kf[e] = d < 64 ? bf2f(kvm[(k0 + key) * 1024 + h * 128 + d]) : bf2f(kpe[(k0 + key) * 32 + (d - 64)]); }
            for (int e = tid; e < 64 * 64; e += 256) { const int key = e >> 6, d = e & 63; Vf[e] = bf2f(kvm[(k0 + key) * 1024 + h * 128 + 64 + d]); }
            __syncthreads();
            for (int key = 0; key < 64; key += 4) {
                float s[4];
#pragma unroll
                for (int c = 0; c < 4; ++c) { float a = 0.f; const f32x4* kr = (const f32x4*)(Kf + (key + c) * 96);
#pragma unroll
                    for (int d4 = 0; d4 < 24; ++d4) { const f32x4 kv = kr[d4]; a += q[4 * d4] * kv[0]; a += q[4 * d4 + 1] * kv[1]; a += q[4 * d4 + 2] * kv[2]; a += q[4 * d4 + 3] * kv[3]; }
                    s[c] = a; }
                const float mn = fmaxf(fmaxf(fmaxf(s[0], s[1]), fmaxf(s[2], s[3])), m);
                const float alpha = __builtin_exp2f(m - mn);
                float pe[4];
#pragma unroll
                for (int c = 0; c < 4; ++c) pe[c] = __builtin_exp2f(s[c] - mn);
                l = l * alpha + (pe[0] + pe[1]) + (pe[2] + pe[3]); m = mn;
#pragma unroll
                for (int d4 = 0; d4 < 16; ++d4) {
                    f32x4 a = (f32x4){o[4 * d4], o[4 * d4 + 1], o[4 * d4 + 2], o[4 * d4 + 3]} * alpha;
#pragma unroll
                    for (int c = 0; c < 4; ++c) a += pe[c] * ((const f32x4*)(Vf + (key + c) * 64))[d4];
                    o[4 * d4] = a[0]; o[4 * d4 + 1] = a[1]; o[4 * d4 + 2] = a[2]; o[4 * d4 + 3] = a[3];
                }
            }
        }
        const float il = 1.f / l;
        bf16_t* op = ao + token * 1024 + 512 + h * 64;
#pragma unroll
        for (int d8 = 0; d8 < 8; ++d8) *(u32x4*)(op + 8 * d8) = (u32x4){pk2(o[8 * d8] * il, o[8 * d8 + 1] * il), pk2(o[8 * d8 + 2] * il, o[8 * d8 + 3] * il), pk2(o[8 * d8 + 4] * il, o[8 * d8 + 5] * il), pk2(o[8 * d8 + 6] * il, o[8 * d8 + 7] * il)};
    }
}

__device__ void stage_ln(float* y, const float* __restrict__ g, const float* __restrict__ bta, bf16_t* ob, int bid, int nb) {
    const int lane = threadIdx.x & 63, gw = bid * (blockDim.x >> 6) + (threadIdx.x >> 6), ngw = nb * (blockDim.x >> 6);
    for (int row = gw; row < M; row += ngw) {
        f32x4* yr = (f32x4*)(y + (size_t)row * DM) + lane;
        f32x4 v[4]; float s = 0.f;
#pragma unroll
        for (int j = 0; j < 4; ++j) { v[j] = yr[64 * j]; s += (v[j][0] + v[j][1]) + (v[j][2] + v[j][3]); }
        const float mean = wave_sum(s) * (1.f / DM); float s2 = 0.f;
#pragma unroll
        for (int j = 0; j < 4; ++j) { v[j] = v[j] - mean; s2 += (v[j][0] * v[j][0] + v[j][1] * v[j][1]) + (v[j][2] * v[j][2] + v[j][3] * v[j][3]); }
        const float rstd = rsqrtf(wave_sum(s2) * (1.f / DM) + LN_EPS);
#pragma unroll
        for (int j = 0; j < 4; ++j) {
            const f32x4 gg = ((const f32x4*)g)[lane + 64 * j], bb = ((const f32x4*)bta)[lane + 64 * j];
            const f32x4 o = v[j] * rstd * gg + bb;
            yr[64 * j] = o;
            if (ob) *(u32x2*)(ob + (size_t)row * DM + 4 * (lane + 64 * j)) = (u32x2){pk2(o[0], o[1]), pk2(o[2], o[3])};
        }
    }
}

constexpr int NPHASE = 12;
__device__ __forceinline__ void run_phase(int ph, const Params& p, float* smem, int bid, int nb) {
    unsigned char* ws = p.ws;
    switch (ph) {
    case 0: stage0(p, smem, bid, nb); break;
    case 1: { EpiH e{(bf16_t*)(ws + WS_QKV), (bf16_t*)(ws + WS_LAT), (bf16_t*)(ws + WS_G)};
              gemm_v1<false>((const bf16_t*)(ws + WS_XB), DM, (const bf16_t*)(ws + WS_WIN), DM, HP / 128, 128, 0, e, bid, nb); } break;
    case 2: stage_lat(p, bid, nb); break;
    case 3: { EpiQ e{(bf16_t*)(ws + WS_QM), (const float2*)(ws + WS_ROPE)};
              gemm_v1<false>((const bf16_t*)(ws + WS_QLN), QLORA, (const bf16_t*)(ws + WS_WUQ), QLORA, 768 / 128, 128, 0, e, bid, nb);
              EpiPlain e2{(bf16_t*)(ws + WS_KVM), 1024};
              gemm_v1<false>((const bf16_t*)(ws + WS_KVLN), KVLORA, (const bf16_t*)(ws + WS_WUKV), KVLORA, 1024 / 128, 128, 0, e2, bid, nb); } break;
    case 4: stage_na(p, bid, nb); stage_mla(p, smem, bid, nb); break;
    case 5: { EpiGateA e{p.out, (const bf16_t*)(ws + WS_G), p.b_gate};
              gemm_v1<false>((const bf16_t*)(ws + WS_AO), 1024, (const bf16_t*)(ws + WS_WBNA), 512, DM / 128, 128, 0, e, bid, nb); } break;
    case 6: { EpiGateB e{p.out, (const bf16_t*)(ws + WS_G), p.b_gate, (bf16_t*)(ws + WS_MG)};
              gemm_v1<false>((const bf16_t*)(ws + WS_AO) + 512, 1024, (const bf16_t*)(ws + WS_WBMLA), 512, DM / 128, 128, 0, e, bid, nb); } break;
    case 7: { EpiRes e{p.x, p.out};
              gemm_v1<false>((const bf16_t*)(ws + WS_MG), DM, (const bf16_t*)(ws + WS_WOUT), DM, DM / 128, 128, 0, e, bid, nb); } break;
    case 8: stage_ln(p.out, p.ln1g, p.ln1b, (bf16_t*)(ws + WS_X1B), bid, nb); break;
    case 9: { EpiSwiglu e{(bf16_t*)(ws + WS_HID)};
              gemm_v1<true>((const bf16_t*)(ws + WS_X1B), DM, (const bf16_t*)(ws + WS_WFI), DM, FFH / 128, 256, 128, e, bid, nb); } break;
    case 10: { EpiRes e{p.out, p.out};
               gemm_v1<false>((const bf16_t*)(ws + WS_HID), FFH, (const bf16_t*)(ws + WS_WFO), FFH, DM / 128, 128, 0, e, bid, nb); } break;
    case 11: stage_ln(p.out, p.ln2g, p.ln2b, nullptr, bid, nb); break;
    }
}

constexpr int SMEM_FLOATS = 64 * 96 + 64 * 64;
#if FUSED
__global__ void __launch_bounds__(256) fwd_megakernel(Params p) {
    __shared__ __attribute__((aligned(16))) float smem[SMEM_FLOATS];
    cg::grid_group grid = cg::this_grid();
    for (int ph = 0; ph < NPHASE; ++ph) {
        run_phase(ph, p, smem, blockIdx.x, gridDim.x);
        if (ph + 1 < NPHASE) grid.sync();
    }
}
#else
template <int PH> __global__ void __launch_bounds__(256) phase_kernel(Params p) {
    __shared__ __attribute__((aligned(16))) float smem[SMEM_FLOATS];
    run_phase(PH, p, smem, blockIdx.x, gridDim.x);
}
template <int PH> static void launch_phase(const Params& p, hipStream_t stream) {
    hipLaunchKernelGGL(phase_kernel<PH>, dim3(1024), dim3(256), 0, stream, p);
    if constexpr (PH + 1 < NPHASE) launch_phase<PH + 1>(p, stream);
}
#endif

extern "C" void kernel_launch(void* const* d_in, const int* in_sizes, int n_in, void* d_out, int out_size, void* d_ws, size_t ws_size, hipStream_t stream) {
    if (n_in != 17 || out_size != M * DM || ws_size < WS_END) { fprintf(stderr, "kernel_launch: unexpected shapes (n_in %d, out %d, ws %zu)\n", n_in, out_size, ws_size); return; }
    Params p{};
    p.x = (const float*)d_in[0]; p.w_in = (const float*)d_in[1]; p.b_gate = (const float*)d_in[2]; p.rpb = (const float*)d_in[3]; p.qn = (const float*)d_in[4];
    p.w_uq = (const float*)d_in[5]; p.kvn = (const float*)d_in[6]; p.w_ukv = (const float*)d_in[7]; p.w_bna = (const float*)d_in[8]; p.w_bmla = (const float*)d_in[9];
    p.w_out = (const float*)d_in[10]; p.ln1g = (const float*)d_in[11]; p.ln1b = (const float*)d_in[12]; p.w_fi = (const float*)d_in[13]; p.w_fo = (const float*)d_in[14];
    p.ln2g = (const float*)d_in[15]; p.ln2b = (const float*)d_in[16];
    p.out = (float*)d_out; p.ws = (unsigned char*)d_ws;
#if FUSED
    static int grid_blocks = 0;
    if (!grid_blocks) {
        int dev = 0, cus = 0, per_cu = 0;
        hipGetDevice(&dev);
        hipDeviceGetAttribute(&cus, hipDeviceAttributeMultiprocessorCount, dev);
        hipOccupancyMaxActiveBlocksPerMultiprocessor(&per_cu, fwd_megakernel, 256, 0);
        if (per_cu < 1) per_cu = 1;
        grid_blocks = cus * per_cu;
    }
    void* args[] = {&p};
    hipError_t e = hipLaunchCooperativeKernel((void*)fwd_megakernel, dim3(grid_blocks), dim3(256), args, 0, stream);
    if (e != hipSuccess) fprintf(stderr, "cooperative launch failed: %s (grid %d)\n", hipGetErrorString(e), grid_blocks);
#else
    launch_phase<0>(p, stream);
#endif
}
```

```cpp
#include <hip/hip_runtime.h>
#include <hip/hip_cooperative_groups.h>
#include <cstdint>
#include <cstdio>
namespace cg = cooperative_groups;

#ifndef FUSED
#define FUSED 1
#endif

constexpr int M = 16384, DM = 1024, SEQ = 4096, GRIDW = 64;
constexpr int NAH = 8;
constexpr int QLORA = 256, KVLORA = 128, QK = 96, MH = 8;
constexpr int FFH = 2816;
constexpr int HP = 4096;
constexpr float LOG2E = 1.4426950408889634f;
constexpr float DN_ALPHA = 1.189207115002721f;
constexpr float LN_EPS = 1e-5f, RMS_EPS = 1e-6f;
constexpr int NTHREADS = 512;

constexpr size_t MiB = 1u << 20;
constexpr size_t WS_ROPE = 64 * 1024;
constexpr size_t WS_WIN = 1 * MiB;
constexpr size_t WS_WUQ = 9 * MiB;
constexpr size_t WS_WUKV = 9 * MiB + 512 * 1024;
constexpr size_t WS_WBNA = 10 * MiB;
constexpr size_t WS_WBMLA = 11 * MiB;
constexpr size_t WS_WOUT = 12 * MiB;
constexpr size_t WS_WFI = 14 * MiB;
constexpr size_t WS_WFO = 25 * MiB;
constexpr size_t WS_XB = 32 * MiB;
constexpr size_t WS_QM = 32 * MiB;
constexpr size_t WS_KPE = 56 * MiB;
constexpr size_t WS_MG = 32 * MiB;
constexpr size_t WS_QKV = 64 * MiB;
constexpr size_t WS_X1B = 64 * MiB;
constexpr size_t WS_LAT = 112 * MiB;
constexpr size_t WS_G = 128 * MiB;
constexpr size_t WS_HID = 128 * MiB;
constexpr size_t WS_KVM = 192 * MiB;
constexpr size_t WS_AO = 224 * MiB;
constexpr size_t WS_END = 256 * MiB;

struct Params {
    const float *x, *w_in, *b_gate, *rpb, *qn, *w_uq, *kvn, *w_ukv, *w_bna, *w_bmla, *w_out, *ln1g, *ln1b, *w_fi, *w_fo, *ln2g, *ln2b;
    float* out; unsigned char* ws; int ph_lo, ph_hi;
};

namespace pg8 {
#define PG8_LAS __attribute__((address_space(3)))
typedef unsigned short bf16_t;
typedef short bf16x8 __attribute__((ext_vector_type(8)));
typedef float f32x4 __attribute__((ext_vector_type(4)));
typedef unsigned u32x4 __attribute__((ext_vector_type(4)));
constexpr int BM = 256, BK = 64, HALF = 128, HTB = HALF * BK * 2  , STAGE_BYTES = 8 * HTB, NXCD = 8, WGM = 8;

__host__ __device__ __forceinline__ int lds_byte(int r, int c) { const int st = (r >> 4) * 2 + (c >> 5), rr = r & 15, cc = c & 31, ob = rr * 64 + cc * 2; return st * 1024 + (ob ^ (((ob >> 9) & 1) << 5)); }
__host__ __device__ __forceinline__ void stage_rc(int b, int& R, int& C) { const int st = b / 1024, sb = b % 1024, swz = sb ^ (((sb >> 9) & 1) << 5); R = (st >> 1) * 16 + swz / 64; C = (st & 1) * 32 + (swz % 64) / 2; }
__host__ __device__ __forceinline__ int perm32(int rho) { const int n = rho >> 4, i = rho & 15; return 8 * (i >> 2) + 4 * n + (i & 3); }

struct Unit { int pm, pn; };
struct Gemm { const bf16_t* A; const bf16_t* Bt; int M, N, K, lda, ldb; };

struct StaticOrder {
    int nM, nN, nwg, G, c;
    __host__ __device__ void init(int M, int N, int G_, int c_) { nM = M / BM; nN = N / BM; nwg = nM * nN; G = G_; c = c_; }
    __host__ __device__ bool next(int i, Unit& u) const {
        const long L = (long)i * G + c; if (L >= nwg) return false;
        int wgid = (int)L; { const int q = nwg / NXCD, r = nwg % NXCD, xcd = wgid % NXCD, off = wgid / NXCD; wgid = (xcd < r ? xcd * (q + 1) : r * (q + 1) + (xcd - r) * q) + off; }
        const int nig = WGM * nN, gid = wgid / nig, fm = gid * WGM, gsz = (nM - fm) < WGM ? (nM - fm) : WGM;
        u.pm = fm + ((wgid % nig) % gsz); u.pn = (wgid % nig) / gsz; return true;
    }
    __device__ __forceinline__ void a_ready(const Unit&) const {}
    __device__ __forceinline__ void done(const Unit&) const {}
};


template <class Epi, class Sched, bool ALIGN_EPI = false, bool SP2 = false>
__device__ __forceinline__ void gemm_phase(PG8_LAS unsigned char* lds, const Gemm g, const Sched& S, const Epi& E) {
    const int tid = threadIdx.x, wid = __builtin_amdgcn_readfirstlane(tid >> 6), lane = tid & 63, wr = wid >> 2, wc = wid & 3, fr = lane & 15, fq = lane >> 4;
    const int K = g.K, nt = K / BK;
    unsigned voffA[2], voffB[2];
#pragma unroll
    for (int i = 0; i < 2; ++i) { int R, C; stage_rc(tid * 16 + i * 8192, R, C); const int Rb = Epi::PERM ? ((R & ~31) + perm32(R & 31)) : R;
        voffA[i] = (unsigned)(R * g.lda + C) * 2u; voffB[i] = (unsigned)(Rb * g.ldb + C) * 2u; }
    const size_t kstep = (size_t)(BK * 2);
    const size_t hstepA = (size_t)HALF * g.lda * 2, hstepB = (size_t)HALF * g.ldb * 2;
    const size_t tstepA = 2 * hstepA, tstepB = 2 * hstepB;
    const unsigned ldsw = (unsigned)wid * 1024u;
    const int aoff = lds_byte(wr * 64 + fr, fq * 8), boff = lds_byte(wc * 32 + fr, fq * 8);
#define PG8_SA(b, h) (((b) * 2 + (h)) * HTB)
#define PG8_SB(b, h) ((4 + (b) * 2 + (h)) * HTB)
#define PG8_STAGE(bufoff, gbase, voff) do { _Pragma("unroll") for (int _i = 0; _i < 2; ++_i) \
        __builtin_amdgcn_global_load_lds((const unsigned*)((const char*)(gbase) + (voff)[_i]), (PG8_LAS unsigned*)(lds + (bufoff) + ldsw + _i * 8192), 16, 0, 0); } while (0)
#define PG8_LDA(dst, b, h) do { _Pragma("unroll") for (int m = 0; m < 4; ++m) _Pragma("unroll") for (int k = 0; k < 2; ++k) dst[m][k] = *(const PG8_LAS bf16x8*)(lds + PG8_SA(b, h) + aoff + m * 2048 + k * 1024); } while (0)
#define PG8_LDB(dst, b, h) do { _Pragma("unroll") for (int n = 0; n < 2; ++n) _Pragma("unroll") for (int k = 0; k < 2; ++k) dst[n][k] = *(const PG8_LAS bf16x8*)(lds + PG8_SB(b, h) + boff + n * 2048 + k * 1024); } while (0)
#define PG8_MMA(ai, bj, At, Bt) do { __builtin_amdgcn_s_setprio(1); _Pragma("unroll") for (int m = 0; m < 4; ++m) _Pragma("unroll") for (int n = 0; n < 2; ++n) _Pragma("unroll") for (int k = 0; k < 2; ++k) \
        acc[ai][bj][m][n] = __builtin_amdgcn_mfma_f32_16x16x32_bf16(Bt[n][k], At[m][k], acc[ai][bj][m][n], 0, 0, 0); __builtin_amdgcn_s_setprio(0); } while (0)
#define PG8_WAIT_V(n) asm volatile("s_waitcnt vmcnt(" #n ")" ::: "memory")
#define PG8_WAIT_L(n) asm volatile("s_waitcnt lgkmcnt(" #n ")" ::: "memory")
#define PG8_BAR __builtin_amdgcn_s_barrier()
#define PG8_SCHED __builtin_amdgcn_sched_barrier(0)
    Unit cur, nxt; int ui = 0;
    if (!S.next(0, cur)) return;
    f32x4 acc[2][2][4][2];
#pragma unroll
    for (int a = 0; a < 2; ++a)
#pragma unroll
        for (int b = 0; b < 2; ++b)
#pragma unroll
            for (int m = 0; m < 4; ++m)
#pragma unroll
                for (int n = 0; n < 2; ++n) acc[a][b][m][n] = (f32x4){0.f, 0.f, 0.f, 0.f};
    bf16x8 At[4][2], B0[2][2], B1[2][2];
    const char* cA = (const char*)g.A + (size_t)cur.pm * tstepA; const char* cB = (const char*)g.Bt + (size_t)cur.pn * tstepB;
    S.a_ready(cur);
    if constexpr (SP2) {
        PG8_STAGE(PG8_SB(0, 0), cB, voffB); PG8_STAGE(PG8_SB(0, 1), cB + hstepB, voffB); PG8_STAGE(PG8_SA(0, 0), cA, voffA); PG8_STAGE(PG8_SA(0, 1), cA + hstepA, voffA);
        if (wr == 1) PG8_BAR;
        PG8_WAIT_V(2); PG8_BAR;
        PG8_STAGE(PG8_SB(1, 0), cB + kstep, voffB); PG8_STAGE(PG8_SA(1, 0), cA + kstep, voffA); PG8_STAGE(PG8_SB(1, 1), cB + hstepB + kstep, voffB);
        PG8_WAIT_V(6); PG8_BAR;
    } else {
        PG8_STAGE(PG8_SB(0, 0), cB, voffB); PG8_STAGE(PG8_SA(0, 0), cA, voffA); PG8_STAGE(PG8_SB(0, 1), cB + hstepB, voffB); PG8_STAGE(PG8_SA(0, 1), cA + hstepA, voffA);
        if (wr == 1) PG8_BAR;
        PG8_WAIT_V(4); PG8_BAR;
        PG8_STAGE(PG8_SB(1, 0), cB + kstep, voffB); PG8_STAGE(PG8_SA(1, 0), cA + kstep, voffA); PG8_STAGE(PG8_SB(1, 1), cB + hstepB + kstep, voffB);
        PG8_WAIT_V(6); PG8_BAR;
    }
    for (;;) {
        const bool has_next = S.next(ui + 1, nxt);
        const char* nA = has_next ? (const char*)g.A + (size_t)nxt.pm * tstepA : cA; const char* nB = has_next ? (const char*)g.Bt + (size_t)nxt.pn * tstepB : cB;
#pragma unroll 1
        for (int t = 0; t < nt; t += 2) {
            const bool last = (t == nt - 2);
            const char* a1 = cA + (size_t)(t + 1) * kstep;
            const char* a2 = last ? nA : cA + (size_t)(t + 2) * kstep; const char* b2 = last ? nB : cB + (size_t)(t + 2) * kstep;
            const char* a3 = a2 + kstep; const char* b3 = b2 + kstep;
            if (last && has_next) S.a_ready(nxt);
            if constexpr (SP2) {
            PG8_LDB(B0, 0, 0); PG8_LDB(B1, 0, 1); PG8_SCHED; PG8_LDA(At, 0, 0); PG8_STAGE(PG8_SA(1, 1), a1 + hstepA, voffA);
            PG8_WAIT_V(8); PG8_WAIT_L(0); PG8_BAR; PG8_MMA(0, 0, At, B0); PG8_MMA(0, 1, At, B1); PG8_BAR; PG8_SCHED;
            PG8_LDA(At, 0, 1); PG8_STAGE(PG8_SB(0, 0), b2, voffB); PG8_STAGE(PG8_SB(0, 1), b2 + hstepB, voffB); PG8_STAGE(PG8_SA(0, 0), a2, voffA);
            PG8_WAIT_V(8); PG8_WAIT_L(0); PG8_BAR; PG8_MMA(1, 0, At, B0); PG8_MMA(1, 1, At, B1); PG8_BAR; PG8_SCHED;
            PG8_LDB(B0, 1, 0); PG8_LDB(B1, 1, 1); PG8_SCHED; PG8_LDA(At, 1, 0); PG8_STAGE(PG8_SA(0, 1), a2 + hstepA, voffA);
            PG8_WAIT_V(8); PG8_WAIT_L(0); PG8_BAR; PG8_MMA(0, 0, At, B0); PG8_MMA(0, 1, At, B1); PG8_BAR; PG8_SCHED;
            PG8_LDA(At, 1, 1); PG8_STAGE(PG8_SB(1, 0), b3, voffB); PG8_STAGE(PG8_SB(1, 1), b3 + hstepB, voffB); PG8_STAGE(PG8_SA(1, 0), a3, voffA);
            PG8_WAIT_V(8); PG8_WAIT_L(0); PG8_BAR; PG8_MMA(1, 0, At, B0); PG8_MMA(1, 1, At, B1); PG8_BAR; PG8_SCHED;
            } else {
            PG8_LDB(B0, 0, 0); PG8_SCHED; PG8_LDA(At, 0, 0); PG8_STAGE(PG8_SA(1, 1), a1 + hstepA, voffA);
            PG8_WAIT_L(8); PG8_BAR; PG8_WAIT_L(0); PG8_MMA(0, 0, At, B0); PG8_BAR; PG8_SCHED;
            PG8_LDB(B1, 0, 1); PG8_STAGE(PG8_SB(0, 0), b2, voffB);
            PG8_BAR; PG8_WAIT_L(0); PG8_MMA(0, 1, At, B1); PG8_BAR;
            PG8_LDA(At, 0, 1); PG8_STAGE(PG8_SA(0, 0), a2, voffA);
            PG8_BAR; PG8_WAIT_L(0); PG8_MMA(1, 0, At, B0); PG8_BAR; PG8_SCHED;
            PG8_STAGE(PG8_SB(0, 1), b2 + hstepB, voffB);
            PG8_WAIT_V(6); PG8_BAR; PG8_MMA(1, 1, At, B1); PG8_BAR;
            PG8_LDB(B0, 1, 0); PG8_SCHED; PG8_LDA(At, 1, 0); PG8_STAGE(PG8_SA(0, 1), a2 + hstepA, voffA);
            PG8_WAIT_L(8); PG8_BAR; PG8_WAIT_L(0); PG8_MMA(0, 0, At, B0); PG8_BAR; PG8_SCHED;
            PG8_LDB(B1, 1, 1); PG8_STAGE(PG8_SB(1, 0), b3, voffB);
            PG8_BAR; PG8_WAIT_L(0); PG8_MMA(0, 1, At, B1); PG8_BAR;
            PG8_LDA(At, 1, 1); PG8_STAGE(PG8_SA(1, 0), a3, voffA);
            PG8_BAR; PG8_WAIT_L(0); PG8_MMA(1, 0, At, B0); PG8_BAR; PG8_SCHED;
            PG8_STAGE(PG8_SB(1, 1), b3 + hstepB, voffB);
            PG8_WAIT_V(6); PG8_BAR; PG8_MMA(1, 1, At, B1); PG8_BAR;
            }
        }
        if constexpr (ALIGN_EPI) { if (wr == 0) PG8_BAR; }
        if constexpr (!Epi::AFTER_DRAIN) { E(acc, cur, wr, wc, fr, fq); S.done(cur); }
        if (!has_next) break;
#pragma unroll
        for (int a = 0; a < 2; ++a)
#pragma unroll
            for (int b = 0; b < 2; ++b)
#pragma unroll
                for (int m = 0; m < 4; ++m)
#pragma unroll
                    for (int n = 0; n < 2; ++n) acc[a][b][m][n] = (f32x4){0.f, 0.f, 0.f, 0.f};
        cur = nxt; cA = nA; cB = nB; ++ui;
        if constexpr (ALIGN_EPI) { if (wr == 1) PG8_BAR; }
    }
    PG8_WAIT_V(0);
    if constexpr (!ALIGN_EPI) { if (wr == 0) PG8_BAR; }
    PG8_BAR;
    if constexpr (Epi::AFTER_DRAIN) { E.fused(acc, cur, wr, wc, fr, fq, lds, wid, lane); S.done(cur); }
#undef PG8_SA
#undef PG8_SB
#undef PG8_STAGE
#undef PG8_LDA
#undef PG8_LDB
#undef PG8_MMA
#undef PG8_WAIT_V
#undef PG8_WAIT_L
#undef PG8_BAR
#undef PG8_SCHED
}
}

using pg8::bf16_t; using pg8::bf16x8; using pg8::f32x4; using pg8::u32x4; using pg8::Unit;
typedef unsigned u32x2 __attribute__((ext_vector_type(2)));
typedef float f32x2_t __attribute__((ext_vector_type(2)));
typedef __bf16 bf16x2_t __attribute__((ext_vector_type(2)));
#define LAS __attribute__((address_space(3)))

__device__ __forceinline__ unsigned f2bf(float f) { unsigned u = __builtin_bit_cast(unsigned, f); return (u + 0x7fffu + ((u >> 16) & 1u)) >> 16; }
__device__ __forceinline__ float bf2f(unsigned b) { return __builtin_bit_cast(float, b << 16); }
__device__ __forceinline__ float bflo(unsigned w) { return __builtin_bit_cast(float, w << 16); }
__device__ __forceinline__ float bfhi(unsigned w) { return __builtin_bit_cast(float, w & 0xffff0000u); }
__device__ __forceinline__ unsigned pk2(float lo, float hi) { f32x2_t v = {lo, hi}; bf16x2_t b = __builtin_convertvector(v, bf16x2_t); return __builtin_bit_cast(unsigned, b); }
__device__ __forceinline__ float wave_sum(float v) {
#pragma unroll
    for (int o = 1; o < 64; o <<= 1) v += __shfl_xor(v, o);
    return v;
}
__device__ __forceinline__ float sigmoidf_(float z) { return __builtin_amdgcn_rcpf(1.f + __builtin_amdgcn_exp2f(-z * LOG2E)); }
__device__ __forceinline__ int rope_perm(int p) { return (p >> 4) * 16 + (p & 1) * 8 + ((p & 15) >> 1); }

typedef const f32x4 (&AccRef)[2][2][4][2];
__device__ __forceinline__ void store_bf16_tile(AccRef acc, bf16_t* base, int ldc, int row0, int col0) {
#pragma unroll
    for (int ai = 0; ai < 2; ++ai)
#pragma unroll
        for (int m = 0; m < 4; ++m) { bf16_t* rowp = base + (size_t)(row0 + ai * 128 + m * 16) * ldc + col0;
#pragma unroll
            for (int bj = 0; bj < 2; ++bj) { const f32x4 v0 = acc[ai][bj][m][0], v1 = acc[ai][bj][m][1];
                *(u32x4*)(rowp + bj * 128) = (u32x4){pk2(v0[0], v0[1]), pk2(v0[2], v0[3]), pk2(v1[0], v1[1]), pk2(v1[2], v1[3])}; } }
}
struct EpiG1 {
    static constexpr bool PERM = true, AFTER_DRAIN = false;
    bf16_t *qkv, *lat, *g;
    __device__ __forceinline__ void operator()(AccRef acc, const Unit& u, int wr, int wc, int fr, int fq) const {
        bf16_t* base; int ldc, colt;
        if (u.pn < 6) { base = qkv; ldc = 1536; colt = u.pn * 256; } else if (u.pn < 8) { base = lat; ldc = 512; colt = (u.pn - 6) * 256; } else { base = g; ldc = 2048; colt = (u.pn - 8) * 256; }
        store_bf16_tile(acc, base, ldc, u.pm * 256 + wr * 64 + fr, colt + wc * 32 + 8 * fq);
    }
};
struct EpiPlain {
    static constexpr bool PERM = true, AFTER_DRAIN = false;
    bf16_t* base; int ldc;
    __device__ __forceinline__ void operator()(AccRef acc, const Unit& u, int wr, int wc, int fr, int fq) const { store_bf16_tile(acc, base, ldc, u.pm * 256 + wr * 64 + fr, u.pn * 256 + wc * 32 + 8 * fq); }
};
struct EpiQ {
    static constexpr bool PERM = true, AFTER_DRAIN = false;
    bf16_t* qm; const float* tab;
    __device__ __forceinline__ void operator()(AccRef acc, const Unit& u, int wr, int wc, int fr, int fq) const {
        const float sc = 0.10206207261596577f * LOG2E;
        const int row0 = u.pm * 256 + wr * 64 + fr, colb = u.pn * 256 + wc * 32 + 8 * fq;
#pragma unroll
        for (int bj = 0; bj < 2; ++bj) {
            const int col = colb + bj * 128, d0 = col % 96, pidx0 = d0 - 64, part = pidx0 >> 4, i0 = (pidx0 & 15) >> 1;
#pragma unroll
            for (int ai = 0; ai < 2; ++ai)
#pragma unroll
                for (int m = 0; m < 4; ++m) {
                    const int row = row0 + ai * 128 + m * 16;
                    f32x4 v0 = acc[ai][bj][m][0], v1 = acc[ai][bj][m][1];
                    if (d0 >= 64) {
                        const int t = row & (SEQ - 1), pos = part ? (t & 63) : (t >> 6);
                        const f32x4 c0 = *(const f32x4*)(tab + (pos * 8 + i0) * 2), c1 = *(const f32x4*)(tab + (pos * 8 + i0) * 2 + 4);
                        v0 = (f32x4){v0[0] * c0[0] - v0[1] * c0[1], v0[1] * c0[0] + v0[0] * c0[1], v0[2] * c0[2] - v0[3] * c0[3], v0[3] * c0[2] + v0[2] * c0[3]};
                        v1 = (f32x4){v1[0] * c1[0] - v1[1] * c1[1], v1[1] * c1[0] + v1[0] * c1[1], v1[2] * c1[2] - v1[3] * c1[3], v1[3] * c1[2] + v1[2] * c1[3]};
                    }
                    v0 = v0 * sc; v1 = v1 * sc;
                    *(u32x4*)(qm + (size_t)row * 768 + col) = (u32x4){pk2(v0[0], v0[1]), pk2(v0[2], v0[3]), pk2(v1[0], v1[1]), pk2(v1[2], v1[3])};
                    asm volatile("" ::: "memory");
                }
        }
    }
};
template <bool SECOND> struct EpiGate {
    static constexpr bool PERM = true, AFTER_DRAIN = false;
    bf16_t* mg; const bf16_t* g; const float* bg;
    __device__ __forceinline__ void operator()(AccRef acc, const Unit& u, int wr, int wc, int fr, int fq) const {
        const int row0 = u.pm * 256 + wr * 64 + fr, colb = u.pn * 256 + wc * 32 + 8 * fq, goff = SECOND ? 1024 : 0;
#pragma unroll
        for (int bj = 0; bj < 2; ++bj) {
            const int col = colb + bj * 128;
            const f32x4 b0 = *(const f32x4*)(bg + goff + col), b1 = *(const f32x4*)(bg + goff + col + 4);
#pragma unroll
            for (int ai = 0; ai < 2; ++ai)
#pragma unroll
                for (int m = 0; m < 4; ++m) {
                    const int row = row0 + ai * 128 + m * 16;
                    const u32x4 gv = *(const u32x4*)(g + (size_t)row * 2048 + goff + col);
                    const f32x4 a0 = acc[ai][bj][m][0], a1 = acc[ai][bj][m][1];
                    float o[8];
                    o[0] = sigmoidf_(bflo(gv[0]) + b0[0]) * a0[0]; o[1] = sigmoidf_(bfhi(gv[0]) + b0[1]) * a0[1];
                    o[2] = sigmoidf_(bflo(gv[1]) + b0[2]) * a0[2]; o[3] = sigmoidf_(bfhi(gv[1]) + b0[3]) * a0[3];
                    o[4] = sigmoidf_(bflo(gv[2]) + b1[0]) * a1[0]; o[5] = sigmoidf_(bfhi(gv[2]) + b1[1]) * a1[1];
                    o[6] = sigmoidf_(bflo(gv[3]) + b1[2]) * a1[2]; o[7] = sigmoidf_(bfhi(gv[3]) + b1[3]) * a1[3];
                    u32x4* dst = (u32x4*)(mg + (size_t)row * DM + col);
                    if (SECOND) { const u32x4 old = *dst;
#pragma unroll
                        for (int e = 0; e < 4; ++e) { o[2 * e] += bflo(old[e]); o[2 * e + 1] += bfhi(old[e]); } }
                    *dst = (u32x4){pk2(o[0], o[1]), pk2(o[2], o[3]), pk2(o[4], o[5]), pk2(o[6], o[7])};
                }
        }
    }
};
struct EpiRes {
    static constexpr bool PERM = false, AFTER_DRAIN = false;
    const float* base; float* y;
    __device__ __forceinline__ void operator()(AccRef acc, const Unit& u, int wr, int wc, int fr, int fq) const {
#pragma unroll
        for (int ai = 0; ai < 2; ++ai)
#pragma unroll
            for (int m = 0; m < 4; ++m) { const size_t roff = (size_t)(u.pm * 256 + ai * 128 + wr * 64 + m * 16 + fr) * DM + u.pn * 256 + wc * 32 + 4 * fq;
#pragma unroll
                for (int bj = 0; bj < 2; ++bj)
#pragma unroll
                    for (int n = 0; n < 2; ++n) { const size_t off = roff + bj * 128 + n * 16; const f32x4 b = *(const f32x4*)(base + off); *(f32x4*)(y + off) = b * DN_ALPHA + acc[ai][bj][m][n]; } }
    }
};
struct EpiSwiglu {
    static constexpr bool PERM = true, AFTER_DRAIN = false;
    bf16_t* hid;
    __device__ __forceinline__ void operator()(AccRef acc, const Unit& u, int wr, int wc, int fr, int fq) const {
        const int row0 = u.pm * 256 + wr * 64 + fr, col = u.pn * 128 + wc * 32 + 8 * fq;
#pragma unroll
        for (int ai = 0; ai < 2; ++ai)
#pragma unroll
            for (int m = 0; m < 4; ++m) {
                const f32x4 g0 = acc[ai][0][m][0], g1 = acc[ai][0][m][1], u0 = acc[ai][1][m][0], u1 = acc[ai][1][m][1];
                float o[8];
#pragma unroll
                for (int e = 0; e < 4; ++e) { o[e] = g0[e] * sigmoidf_(g0[e]) * u0[e]; o[4 + e] = g1[e] * sigmoidf_(g1[e]) * u1[e]; }
                *(u32x4*)(hid + (size_t)(row0 + ai * 128 + m * 16) * FFH + col) = (u32x4){pk2(o[0], o[1]), pk2(o[2], o[3]), pk2(o[4], o[5]), pk2(o[6], o[7])};
            }
    }
};

__device__ __forceinline__ int colmap(int mode, int n) {
    if (mode == 1) {
        if (n < 1920) return n;
        if (n < 1952) return 1920 + rope_perm(n - 1920);
        if (n < 2048) return -1;
        return n - 96;
    }
    if (mode == 2) {
        const int h = n / 96, d = n % 96;
        return d < 64 ? n : h * 96 + 64 + rope_perm(d - 64);
    }
    if (mode == 3) {
        const int t = n >> 8, w = n & 255;
        return w < 128 ? 128 * t + w : FFH + 128 * t + (w - 128);
    }
    return n;
}
__device__ void transpose_w(const float* __restrict__ W, int K, int Nsrc, bf16_t* __restrict__ Wt, int ldk, int Ndst, int mode, float* tile, int bid, int nb) {
    const int tid = threadIdx.x, nw = blockDim.x >> 6, nkt = K / 64, nnt = Ndst / 64;
    for (int t = bid; t < nkt * nnt; t += nb) {
        const int kt = t / nnt, nt = t % nnt;
        const int n = nt * 64 + (tid & 63), src = colmap(mode, n);
        for (int kl = tid >> 6; kl < 64; kl += nw) tile[kl * 65 + (tid & 63)] = src >= 0 ? W[(size_t)(kt * 64 + kl) * Nsrc + src] : 0.f;
        __syncthreads();
        for (int nl = tid >> 6; nl < 64; nl += nw) Wt[(size_t)(nt * 64 + nl) * ldk + kt * 64 + (tid & 63)] = (bf16_t)f2bf(tile[(tid & 63) * 65 + nl]);
        __syncthreads();
    }
}
__device__ void stage0(const Params& p, float* smem, int bid, int nb) {
    unsigned char* ws = p.ws;
    transpose_w(p.w_in, DM, 4000, (bf16_t*)(ws + WS_WIN), DM, HP, 1, smem, bid, nb);
    transpose_w(p.w_uq, QLORA, MH * QK, (bf16_t*)(ws + WS_WUQ), QLORA, MH * QK, 2, smem, bid, nb);
    transpose_w(p.w_ukv, KVLORA, 1024, (bf16_t*)(ws + WS_WUKV), 256, 1024, 0, smem, bid, nb);
    transpose_w(p.w_bna, 512, DM, (bf16_t*)(ws + WS_WBNA), 512, DM, 0, smem, bid, nb);
    transpose_w(p.w_bmla, 512, DM, (bf16_t*)(ws + WS_WBMLA), 512, DM, 0, smem, bid, nb);
    transpose_w(p.w_out, DM, DM, (bf16_t*)(ws + WS_WOUT), DM, DM, 0, smem, bid, nb);
    transpose_w(p.w_fi, DM, 2 * FFH, (bf16_t*)(ws + WS_WFI), DM, 2 * FFH, 3, smem, bid, nb);
    transpose_w(p.w_fo, FFH, DM, (bf16_t*)(ws + WS_WFO), FFH, DM, 0, smem, bid, nb);
    {
        bf16_t* wt = (bf16_t*)(ws + WS_WUKV);
        for (int i = bid * blockDim.x + threadIdx.x; i < 1024 * 16; i += nb * blockDim.x) { const int n = i >> 4, c = i & 15; *(u32x4*)(wt + (size_t)n * 256 + 128 + 8 * c) = (u32x4){0u, 0u, 0u, 0u}; }
    }
    const f32x4* xs = (const f32x4*)p.x; u32x4* xd = (u32x4*)(ws + WS_XB);
    for (size_t i = (size_t)bid * blockDim.x + threadIdx.x; i < (size_t)M * DM / 8; i += (size_t)nb * blockDim.x) {
        const f32x4 a = xs[2 * i], b = xs[2 * i + 1];
        xd[i] = (u32x4){pk2(a[0], a[1]), pk2(a[2], a[3]), pk2(b[0], b[1]), pk2(b[2], b[3])};
    }
    if (bid == 0) {
        float2* tab = (float2*)(ws + WS_ROPE);
        for (int e = threadIdx.x; e < 64 * 8; e += blockDim.x) {
            const int pos = e >> 3, i = e & 7;
            const float inv = __builtin_amdgcn_exp2f(-(float)i * 0.125f * 13.287712379549449f);
            const float rev = (float)pos * inv * 0.15915494309189535f;
            tab[e] = make_float2(__builtin_amdgcn_cosf(rev), __builtin_amdgcn_sinf(rev));
        }
    }
}

__device__ void stage_lat(const Params& p, int bid, int nb) {
    const int lane = threadIdx.x & 63, gw = bid * (blockDim.x >> 6) + (threadIdx.x >> 6), ngw = nb * (blockDim.x >> 6);
    bf16_t* lat = (bf16_t*)(p.ws + WS_LAT); bf16_t* kpe = (bf16_t*)(p.ws + WS_KPE);
    const float2* tab = (const float2*)(p.ws + WS_ROPE);
    for (int row = gw; row < M; row += ngw) {
        bf16_t* lr = lat + (size_t)row * 512;
        {
            const u32x2 v = *(const u32x2*)(lr + 4 * lane);
            const float a0 = bflo(v.x), a1 = bfhi(v.x), a2 = bflo(v.y), a3 = bfhi(v.y);
            const float rs = rsqrtf(wave_sum(a0 * a0 + a1 * a1 + a2 * a2 + a3 * a3) * (1.f / 256.f) + RMS_EPS);
            const f32x4 g = *(const f32x4*)(p.qn + 4 * lane);
            *(u32x2*)(lr + 4 * lane) = (u32x2){pk2(a0 * rs * g[0], a1 * rs * g[1]), pk2(a2 * rs * g[2], a3 * rs * g[3])};
        }
        {
            const unsigned v = *(const unsigned*)(lr + 256 + 2 * lane);
            const float a0 = bflo(v), a1 = bfhi(v);
            const float rs = rsqrtf(wave_sum(a0 * a0 + a1 * a1) * (1.f / 128.f) + RMS_EPS);
            *(unsigned*)(lr + 256 + 2 * lane) = pk2(a0 * rs * p.kvn[2 * lane], a1 * rs * p.kvn[2 * lane + 1]);
        }
        {
            const int pidx = lane & 31, part = pidx >> 4, i = (pidx & 15) >> 1, odd = pidx & 1;
            const float v = bf2f(lr[384 + pidx]);
            const int t = row & (SEQ - 1), pos = part ? (t & 63) : (t >> 6);
            const float2 cs = tab[pos * 8 + i];
            const float partner = __shfl_xor(v, 1);
            const float o = v * cs.x + (odd ? partner : -partner) * cs.y;
            if (lane < 32) kpe[(size_t)row * 32 + pidx] = (bf16_t)f2bf(o);
        }
    }
}

__device__ void stage_na(const Params& p, int bid, int nb) {
    const bf16_t* qkv = (const bf16_t*)(p.ws + WS_QKV); bf16_t* ao = (bf16_t*)(p.ws + WS_AO);
    for (int idx = bid * blockDim.x + threadIdx.x; idx < M * NAH; idx += nb * blockDim.x) {
        const int token = idx % M, h = idx / M;
        const int b = token / SEQ, t = token % SEQ, r = t / GRIDW, c = t % GRIDW;
        int rs = r - 4; rs = rs < 0 ? 0 : (rs > 56 ? 56 : rs);
        int cs = c - 8; cs = cs < 0 ? 0 : (cs > 48 ? 48 : cs);
        float q[64], o[64];
        const bf16_t* qp = qkv + (size_t)token * 1536 + h * 64;
#pragma unroll
        for (int d8 = 0; d8 < 8; ++d8) { const u32x4 v = *(const u32x4*)(qp + 8 * d8);
#pragma unroll
            for (int e = 0; e < 4; ++e) { q[8 * d8 + 2 * e] = bflo(v[e]) * (0.125f * LOG2E); q[8 * d8 + 2 * e + 1] = bfhi(v[e]) * (0.125f * LOG2E); } }
#pragma unroll
        for (int d = 0; d < 64; ++d) o[d] = 0.f;
        float m = -INFINITY, l = 0.f;
        for (int i = 0; i < 8; ++i)
            for (int j = 0; j < 16; ++j) {
                const size_t kt = (size_t)b * SEQ + (rs + i) * GRIDW + cs + j;
                const bf16_t* kp = qkv + kt * 1536 + 512 + h * 64; const bf16_t* vp = kp + 512;
                float s = 0.f;
#pragma unroll
                for (int d8 = 0; d8 < 8; ++d8) { const u32x4 v = *(const u32x4*)(kp + 8 * d8);
#pragma unroll
                    for (int e = 0; e < 4; ++e) { s += q[8 * d8 + 2 * e] * bflo(v[e]); s += q[8 * d8 + 2 * e + 1] * bfhi(v[e]); } }
                s += p.rpb[(h * 15 + (rs + i - r + 7)) * 31 + (cs + j - c + 15)] * LOG2E;
                const float mn = fmaxf(m, s), alpha = __builtin_amdgcn_exp2f(m - mn), pe = __builtin_amdgcn_exp2f(s - mn);
                l = l * alpha + pe; m = mn;
#pragma unroll
                for (int d8 = 0; d8 < 8; ++d8) { const u32x4 v = *(const u32x4*)(vp + 8 * d8);
#pragma unroll
                    for (int e = 0; e < 4; ++e) { o[8 * d8 + 2 * e] = o[8 * d8 + 2 * e] * alpha + pe * bflo(v[e]); o[8 * d8 + 2 * e + 1] = o[8 * d8 + 2 * e + 1] * alpha + pe * bfhi(v[e]); } }
            }
        const float il = 1.f / l;
        bf16_t* op = ao + (size_t)token * 1024 + h * 64;
#pragma unroll
        for (int d8 = 0; d8 < 8; ++d8) *(u32x4*)(op + 8 * d8) = (u32x4){pk2(o[8 * d8] * il, o[8 * d8 + 1] * il), pk2(o[8 * d8 + 2] * il, o[8 * d8 + 3] * il), pk2(o[8 * d8 + 4] * il, o[8 * d8 + 5] * il), pk2(o[8 * d8 + 6] * il, o[8 * d8 + 7] * il)};
    }
}

__device__ void stage_mla(const Params& p, float* smem, int bid, int nb) {
    const bf16_t* qm = (const bf16_t*)(p.ws + WS_QM); const bf16_t* kvm = (const bf16_t*)(p.ws + WS_KVM); const bf16_t* kpe = (const bf16_t*)(p.ws + WS_KPE); bf16_t* ao = (bf16_t*)(p.ws + WS_AO);
    float* Kf = smem; float* Vf = smem + 64 * 96;
    const int tid = threadIdx.x;
    for (int unit = bid; unit < 4 * 8 * 8; unit += nb) {
        const int b = unit / 64, h = (unit / 8) % 8, qb = unit % 8;
        const size_t token = (size_t)b * SEQ + qb * 512 + tid;
        float q[96], o[64];
        const bf16_t* qp = qm + token * 768 + h * 96;
#pragma unroll
        for (int d8 = 0; d8 < 12; ++d8) { const u32x4 v = *(const u32x4*)(qp + 8 * d8);
#pragma unroll
            for (int e = 0; e < 4; ++e) { q[8 * d8 + 2 * e] = bflo(v[e]); q[8 * d8 + 2 * e + 1] = bfhi(v[e]); } }
#pragma unroll
        for (int d = 0; d < 64; ++d) o[d] = 0.f;
        float m = -INFINITY, l = 0.f;
        for (int kt = 0; kt < SEQ / 64; ++kt) {
            __syncthreads();
            const size_t k0 = (size_t)b * SEQ + kt * 64;
            for (int e = tid; e < 64 * 96; e += NTHREADS) { const int key = e / 96, d = e % 96;
                Kf[e] = d < 64 ? bf2f(kvm[(k0 + key) * 1024 + h * 128 + d]) : bf2f(kpe[(k0 + key) * 32 + (d - 64)]); }
            for (int e = tid; e < 64 * 64; e += NTHREADS) { const int key = e >> 6, d = e & 63; Vf[e] = bf2f(kvm[(k0 + key) * 1024 + h * 128 + 64 + d]); }
            __syncthreads();
            for (int key = 0; key < 64; key += 4) {
                float s[4];
#pragma unroll
                for (int c = 0; c < 4; ++c) { float a = 0.f; const f32x4* kr = (const f32x4*)(Kf + (key + c) * 96);
#pragma unroll
                    for (int d4 = 0; d4 < 24; ++d4) { const f32x4 kv = kr[d4]; a += q[4 * d4] * kv[0]; a += q[4 * d4 + 1] * kv[1]; a += q[4 * d4 + 2] * kv[2]; a += q[4 * d4 + 3] * kv[3]; }
                    s[c] = a; }
                const float mn = fmaxf(fmaxf(fmaxf(s[0], s[1]), fmaxf(s[2], s[3])), m);
                const float alpha = __builtin_amdgcn_exp2f(m - mn);
                float pe[4];
#pragma unroll
                for (int c = 0; c < 4; ++c) pe[c] = __builtin_amdgcn_exp2f(s[c] - mn);
                l = l * alpha + (pe[0] + pe[1]) + (pe[2] + pe[3]); m = mn;
#pragma unroll
                for (int d4 = 0; d4 < 16; ++d4) {
                    f32x4 a = (f32x4){o[4 * d4], o[4 * d4 + 1], o[4 * d4 + 2], o[4 * d4 + 3]} * alpha;
#pragma unroll
                    for (int c = 0; c < 4; ++c) a += pe[c] * ((const f32x4*)(Vf + (key + c) * 64))[d4];
                    o[4 * d4] = a[0]; o[4 * d4 + 1] = a[1]; o[4 * d4 + 2] = a[2]; o[4 * d4 + 3] = a[3];
                }
            }
        }
        const float il = 1.f / l;
        bf16_t* op = ao + token * 1024 + 512 + h * 64;
#pragma unroll
        for (int d8 = 0; d8 < 8; ++d8) *(u32x4*)(op + 8 * d8) = (u32x4){pk2(o[8 * d8] * il, o[8 * d8 + 1] * il), pk2(o[8 * d8 + 2] * il, o[8 * d8 + 3] * il), pk2(o[8 * d8 + 4] * il, o[8 * d8 + 5] * il), pk2(o[8 * d8 + 6] * il, o[8 * d8 + 7] * il)};
    }
    __syncthreads();
}

__device__ void stage_ln(float* y, const float* __restrict__ g, const float* __restrict__ bta, bf16_t* ob, int bid, int nb) {
    const int lane = threadIdx.x & 63, gw = bid * (blockDim.x >> 6) + (threadIdx.x >> 6), ngw = nb * (blockDim.x >> 6);
    for (int row = gw; row < M; row += ngw) {
        f32x4* yr = (f32x4*)(y + (size_t)row * DM) + lane;
        f32x4 v[4]; float s = 0.f;
#pragma unroll
        for (int j = 0; j < 4; ++j) { v[j] = yr[64 * j]; s += (v[j][0] + v[j][1]) + (v[j][2] + v[j][3]); }
        const float mean = wave_sum(s) * (1.f / DM); float s2 = 0.f;
#pragma unroll
        for (int j = 0; j < 4; ++j) { v[j] = v[j] - mean; s2 += (v[j][0] * v[j][0] + v[j][1] * v[j][1]) + (v[j][2] * v[j][2] + v[j][3] * v[j][3]); }
        const float rstd = rsqrtf(wave_sum(s2) * (1.f / DM) + LN_EPS);
#pragma unroll
        for (int j = 0; j < 4; ++j) {
            const f32x4 gg = ((const f32x4*)g)[lane + 64 * j], bb = ((const f32x4*)bta)[lane + 64 * j];
            const f32x4 o = v[j] * rstd * gg + bb;
            yr[64 * j] = o;
            if (ob) *(u32x2*)(ob + (size_t)row * DM + 4 * (lane + 64 * j)) = (u32x2){pk2(o[0], o[1]), pk2(o[2], o[3])};
        }
    }
}

constexpr int NPHASE = 12;
constexpr int LDS_BYTES = 132 * 1024;
__global__ void __launch_bounds__(NTHREADS, 2) fwd_megakernel(Params p) {
    extern __shared__ __attribute__((aligned(16))) unsigned char lds[];
    cg::grid_group grid = cg::this_grid();
    const int bid = blockIdx.x, nb = gridDim.x;
    LAS unsigned char* ring = (LAS unsigned char*)lds;
    float* smem = (float*)lds;
    unsigned char* ws = p.ws;
#define IN(k) (p.ph_lo <= (k) && (k) < p.ph_hi)
#define SEAM(k) do { if (IN(k) && IN((k) + 1)) grid.sync(); } while (0)
#define BF(off) ((bf16_t*)(ws + (off)))
    typedef pg8::StaticOrder SO;
    if (IN(0)) stage0(p, smem, bid, nb);
    SEAM(0);
    if (IN(1)) { pg8::Gemm g{BF(WS_XB), BF(WS_WIN), M, HP, DM, DM, DM}; SO S; S.init(M, HP, nb, bid); EpiG1 E{BF(WS_QKV), BF(WS_LAT), BF(WS_G)};
        pg8::gemm_phase<EpiG1, SO, true, true>(ring, g, S, E); }
    SEAM(1);
    if (IN(2)) stage_lat(p, bid, nb);
    SEAM(2);
    if (IN(3)) {
        { pg8::Gemm g{BF(WS_LAT) + 256, BF(WS_WUKV), M, 1024, 256, 512, 256}; SO S; S.init(M, 1024, nb, bid); EpiPlain E{BF(WS_KVM), 1024};
          pg8::gemm_phase<EpiPlain, SO, true, true>(ring, g, S, E); }
        { pg8::Gemm g{BF(WS_LAT), BF(WS_WUQ), M, 768, 256, 512, 256}; SO S; S.init(M, 768, nb, (bid + 64) % nb); EpiQ E{BF(WS_QM), (const float*)(ws + WS_ROPE)};
          pg8::gemm_phase<EpiQ, SO, true, true>(ring, g, S, E); }
    }
    SEAM(3);
    if (IN(4)) { stage_na(p, bid, nb); stage_mla(p, smem, bid, nb); }
    SEAM(4);
    if (IN(5)) { pg8::Gemm g{BF(WS_AO), BF(WS_WBNA), M, DM, 512, 1024, 512}; SO S; S.init(M, DM, nb, bid); EpiGate<false> E{BF(WS_MG), BF(WS_G), p.b_gate};
        pg8::gemm_phase<EpiGate<false>, SO, true, true>(ring, g, S, E); }
    SEAM(5);
    if (IN(6)) { pg8::Gemm g{BF(WS_AO) + 512, BF(WS_WBMLA), M, DM, 512, 1024, 512}; SO S; S.init(M, DM, nb, bid); EpiGate<true> E{BF(WS_MG), BF(WS_G), p.b_gate};
        pg8::gemm_phase<EpiGate<true>, SO, true, true>(ring, g, S, E); }
    SEAM(6);
    if (IN(7)) { pg8::Gemm g{BF(WS_MG), BF(WS_WOUT), M, DM, DM, DM, DM}; SO S; S.init(M, DM, nb, bid); EpiRes E{p.x, p.out};
        pg8::gemm_phase<EpiRes, SO, true, true>(ring, g, S, E); }
    SEAM(7);
    if (IN(8)) stage_ln(p.out, p.ln1g, p.ln1b, BF(WS_X1B), bid, nb);
    SEAM(8);
    if (IN(9)) { pg8::Gemm g{BF(WS_X1B), BF(WS_WFI), M, 2 * FFH, DM, DM, DM}; SO S; S.init(M, 2 * FFH, nb, bid); EpiSwiglu E{BF(WS_HID)};
        pg8::gemm_phase<EpiSwiglu, SO, true, true>(ring, g, S, E); }
    SEAM(9);
    if (IN(10)) { pg8::Gemm g{BF(WS_HID), BF(WS_WFO), M, DM, FFH, FFH, FFH}; SO S; S.init(M, DM, nb, bid); EpiRes E{p.out, p.out};
        pg8::gemm_phase<EpiRes, SO, true, true>(ring, g, S, E); }
    SEAM(10);
    if (IN(11)) stage_ln(p.out, p.ln2g, p.ln2b, nullptr, bid, nb);
#undef IN
#undef SEAM
#undef BF
}

extern "C" void kernel_launch(void* const* d_in, const int* in_sizes, int n_in, void* d_out, int out_size, void* d_ws, size_t ws_size, hipStream_t stream) {
    if (n_in != 17 || out_size != M * DM || ws_size < WS_END) { fprintf(stderr, "kernel_launch: unexpected shapes (n_in %d, out %d, ws %zu)\n", n_in, out_size, ws_size); return; }
    Params p{};
    p.x = (const float*)d_in[0]; p.w_in = (const float*)d_in[1]; p.b_gate = (const float*)d_in[2]; p.rpb = (const float*)d_in[3]; p.qn = (const float*)d_in[4];
    p.w_uq = (const float*)d_in[5]; p.kvn = (const float*)d_in[6]; p.w_ukv = (const float*)d_in[7]; p.w_bna = (const float*)d_in[8]; p.w_bmla = (const float*)d_in[9];
    p.w_out = (const float*)d_in[10]; p.ln1g = (const float*)d_in[11]; p.ln1b = (const float*)d_in[12]; p.w_fi = (const float*)d_in[13]; p.w_fo = (const float*)d_in[14];
    p.ln2g = (const float*)d_in[15]; p.ln2b = (const float*)d_in[16];
    p.out = (float*)d_out; p.ws = (unsigned char*)d_ws;
    static int grid_blocks = 0;
    if (!grid_blocks) {
        int dev = 0, cus = 0, per_cu = 0;
        hipGetDevice(&dev);
        hipDeviceGetAttribute(&cus, hipDeviceAttributeMultiprocessorCount, dev);
        hipFuncSetAttribute((const void*)fwd_megakernel, hipFuncAttributeMaxDynamicSharedMemorySize, LDS_BYTES);
        hipOccupancyMaxActiveBlocksPerMultiprocessor(&per_cu, (const void*)fwd_megakernel, NTHREADS, LDS_BYTES);
        if (per_cu < 1) per_cu = 1;
        grid_blocks = cus * per_cu;
    }
#if FUSED
    p.ph_lo = 0; p.ph_hi = NPHASE;
    void* args[] = {&p};
    hipError_t e = hipLaunchCooperativeKernel((const void*)fwd_megakernel, dim3(grid_blocks), dim3(NTHREADS), args, LDS_BYTES, stream);
    if (e != hipSuccess) fprintf(stderr, "cooperative launch failed: %s (grid %d)\n", hipGetErrorString(e), grid_blocks);
#else
    for (int ph = 0; ph < NPHASE; ++ph) { p.ph_lo = ph; p.ph_hi = ph + 1; hipLaunchKernelGGL(fwd_megakernel, dim3(grid_blocks), dim3(NTHREADS), LDS_BYTES, stream, p); }
#endif
}
```

```cpp
#include <hip/hip_runtime.h>
#include <hip/hip_cooperative_groups.h>
#include <cstdint>
#include <cstdio>
namespace cg = cooperative_groups;

#ifndef FUSED
#define FUSED 1
#endif

constexpr int M = 16384, DM = 1024, SEQ = 4096, GRIDW = 64;
constexpr int NAH = 8;
constexpr int QLORA = 256, KVLORA = 128, QK = 96, MH = 8;
constexpr int FFH = 2816;
constexpr int HP = 4096;
constexpr float LOG2E = 1.4426950408889634f;
constexpr float DN_ALPHA = 1.189207115002721f;
constexpr float LN_EPS = 1e-5f, RMS_EPS = 1e-6f;
constexpr int NTHREADS = 512;

constexpr size_t MiB = 1u << 20;
constexpr size_t WS_ROPE = 64 * 1024;
constexpr size_t WS_WIN = 1 * MiB;
constexpr size_t WS_WUQ = 9 * MiB;
constexpr size_t WS_WUKV = 9 * MiB + 512 * 1024;
constexpr size_t WS_WBNA = 10 * MiB;
constexpr size_t WS_WBMLA = 11 * MiB;
constexpr size_t WS_WOUT = 12 * MiB;
constexpr size_t WS_WFI = 14 * MiB;
constexpr size_t WS_WFO = 25 * MiB;
constexpr size_t WS_XB = 32 * MiB;
constexpr size_t WS_QM = 32 * MiB;
constexpr size_t WS_KPE = 56 * MiB;
constexpr size_t WS_MG = 32 * MiB;
constexpr size_t WS_QKV = 64 * MiB;
constexpr size_t WS_X1B = 64 * MiB;
constexpr size_t WS_LAT = 112 * MiB;
constexpr size_t WS_G = 128 * MiB;
constexpr size_t WS_HID = 128 * MiB;
constexpr size_t WS_KVM = 192 * MiB;
constexpr size_t WS_AO = 224 * MiB;
constexpr size_t WS_END = 256 * MiB;

struct Params {
    const float *x, *w_in, *b_gate, *rpb, *qn, *w_uq, *kvn, *w_ukv, *w_bna, *w_bmla, *w_out, *ln1g, *ln1b, *w_fi, *w_fo, *ln2g, *ln2b;
    float* out; unsigned char* ws; int ph_lo, ph_hi;
};

namespace pg8 {
#define PG8_LAS __attribute__((address_space(3)))
typedef unsigned short bf16_t;
typedef short bf16x8 __attribute__((ext_vector_type(8)));
typedef float f32x4 __attribute__((ext_vector_type(4)));
typedef unsigned u32x4 __attribute__((ext_vector_type(4)));
constexpr int BM = 256, BK = 64, HALF = 128, HTB = HALF * BK * 2  , STAGE_BYTES = 8 * HTB, NXCD = 8, WGM = 8;

__host__ __device__ __forceinline__ int lds_byte(int r, int c) { const int st = (r >> 4) * 2 + (c >> 5), rr = r & 15, cc = c & 31, ob = rr * 64 + cc * 2; return st * 1024 + (ob ^ (((ob >> 9) & 1) << 5)); }
__host__ __device__ __forceinline__ void stage_rc(int b, int& R, int& C) { const int st = b / 1024, sb = b % 1024, swz = sb ^ (((sb >> 9) & 1) << 5); R = (st >> 1) * 16 + swz / 64; C = (st & 1) * 32 + (swz % 64) / 2; }
__host__ __device__ __forceinline__ int perm32(int rho) { const int n = rho >> 4, i = rho & 15; return 8 * (i >> 2) + 4 * n + (i & 3); }

struct Unit { int pm, pn; };
struct Gemm { const bf16_t* A; const bf16_t* Bt; int M, N, K, lda, ldb; };

struct StaticOrder {
    int nM, nN, nwg, G, c;
    __host__ __device__ void init(int M, int N, int G_, int c_) { nM = M / BM; nN = N / BM; nwg = nM * nN; G = G_; c = c_; }
    __host__ __device__ bool next(int i, Unit& u) const {
        const long L = (long)i * G + c; if (L >= nwg) return false;
        int wgid = (int)L; { const int q = nwg / NXCD, r = nwg % NXCD, xcd = wgid % NXCD, off = wgid / NXCD; wgid = (xcd < r ? xcd * (q + 1) : r * (q + 1) + (xcd - r) * q) + off; }
        const int nig = WGM * nN, gid = wgid / nig, fm = gid * WGM, gsz = (nM - fm) < WGM ? (nM - fm) : WGM;
        u.pm = fm + ((wgid % nig) % gsz); u.pn = (wgid % nig) / gsz; return true;
    }
    __device__ __forceinline__ void a_ready(const Unit&) const {}
    __device__ __forceinline__ void done(const Unit&) const {}
};


template <class Epi, class Sched, bool ALIGN_EPI = false, bool SP2 = false>
__device__ __forceinline__ void gemm_phase(PG8_LAS unsigned char* lds, const Gemm g, const Sched& S, const Epi& E) {
    const int tid = threadIdx.x, wid = __builtin_amdgcn_readfirstlane(tid >> 6), lane = tid & 63, wr = wid >> 2, wc = wid & 3, fr = lane & 15, fq = lane >> 4;
    const int K = g.K, nt = K / BK;
    unsigned voffA[2], voffB[2];
#pragma unroll
    for (int i = 0; i < 2; ++i) { int R, C; stage_rc(tid * 16 + i * 8192, R, C); const int Rb = Epi::PERM ? ((R & ~31) + perm32(R & 31)) : R;
        voffA[i] = (unsigned)(R * g.lda + C) * 2u; voffB[i] = (unsigned)(Rb * g.ldb + C) * 2u; }
    const size_t kstep = (size_t)(BK * 2);
    const size_t hstepA = (size_t)HALF * g.lda * 2, hstepB = (size_t)HALF * g.ldb * 2;
    const size_t tstepA = 2 * hstepA, tstepB = 2 * hstepB;
    const unsigned ldsw = (unsigned)wid * 1024u;
    const int aoff = lds_byte(wr * 64 + fr, fq * 8), boff = lds_byte(wc * 32 + fr, fq * 8);
#define PG8_SA(b, h) (((b) * 2 + (h)) * HTB)
#define PG8_SB(b, h) ((4 + (b) * 2 + (h)) * HTB)
#define PG8_STAGE(bufoff, gbase, voff) do { _Pragma("unroll") for (int _i = 0; _i < 2; ++_i) \
        __builtin_amdgcn_global_load_lds((const unsigned*)((const char*)(gbase) + (voff)[_i]), (PG8_LAS unsigned*)(lds + (bufoff) + ldsw + _i * 8192), 16, 0, 0); } while (0)
#define PG8_LDA(dst, b, h) do { _Pragma("unroll") for (int m = 0; m < 4; ++m) _Pragma("unroll") for (int k = 0; k < 2; ++k) dst[m][k] = *(const PG8_LAS bf16x8*)(lds + PG8_SA(b, h) + aoff + m * 2048 + k * 1024); } while (0)
#define PG8_LDB(dst, b, h) do { _Pragma("unroll") for (int n = 0; n < 2; ++n) _Pragma("unroll") for (int k = 0; k < 2; ++k) dst[n][k] = *(const PG8_LAS bf16x8*)(lds + PG8_SB(b, h) + boff + n * 2048 + k * 1024); } while (0)
#define PG8_MMA(ai, bj, At, Bt) do { __builtin_amdgcn_s_setprio(1); _Pragma("unroll") for (int m = 0; m < 4; ++m) _Pragma("unroll") for (int n = 0; n < 2; ++n) _Pragma("unroll") for (int k = 0; k < 2; ++k) \
        acc[ai][bj][m][n] = __builtin_amdgcn_mfma_f32_16x16x32_bf16(Bt[n][k], At[m][k], acc[ai][bj][m][n], 0, 0, 0); __builtin_amdgcn_s_setprio(0); } while (0)
#define PG8_WAIT_V(n) asm volatile("s_waitcnt vmcnt(" #n ")" ::: "memory")
#define PG8_WAIT_L(n) asm volatile("s_waitcnt lgkmcnt(" #n ")" ::: "memory")
#define PG8_BAR __builtin_amdgcn_s_barrier()
#define PG8_SCHED __builtin_amdgcn_sched_barrier(0)
    Unit cur, nxt; int ui = 0;
    if (!S.next(0, cur)) return;
    f32x4 acc[2][2][4][2];
#pragma unroll
    for (int a = 0; a < 2; ++a)
#pragma unroll
        for (int b = 0; b < 2; ++b)
#pragma unroll
            for (int m = 0; m < 4; ++m)
#pragma unroll
                for (int n = 0; n < 2; ++n) acc[a][b][m][n] = (f32x4){0.f, 0.f, 0.f, 0.f};
    bf16x8 At[4][2], B0[2][2], B1[2][2];
    const char* cA = (const char*)g.A + (size_t)cur.pm * tstepA; const char* cB = (const char*)g.Bt + (size_t)cur.pn * tstepB;
    S.a_ready(cur);
    if constexpr (SP2) {
        PG8_STAGE(PG8_SB(0, 0), cB, voffB); PG8_STAGE(PG8_SB(0, 1), cB + hstepB, voffB); PG8_STAGE(PG8_SA(0, 0), cA, voffA); PG8_STAGE(PG8_SA(0, 1), cA + hstepA, voffA);
        if (wr == 1) PG8_BAR;
        PG8_WAIT_V(2); PG8_BAR;
        PG8_STAGE(PG8_SB(1, 0), cB + kstep, voffB); PG8_STAGE(PG8_SA(1, 0), cA + kstep, voffA); PG8_STAGE(PG8_SB(1, 1), cB + hstepB + kstep, voffB);
        PG8_WAIT_V(6); PG8_BAR;
    } else {
        PG8_STAGE(PG8_SB(0, 0), cB, voffB); PG8_STAGE(PG8_SA(0, 0), cA, voffA); PG8_STAGE(PG8_SB(0, 1), cB + hstepB, voffB); PG8_STAGE(PG8_SA(0, 1), cA + hstepA, voffA);
        if (wr == 1) PG8_BAR;
        PG8_WAIT_V(4); PG8_BAR;
        PG8_STAGE(PG8_SB(1, 0), cB + kstep, voffB); PG8_STAGE(PG8_SA(1, 0), cA + kstep, voffA); PG8_STAGE(PG8_SB(1, 1), cB + hstepB + kstep, voffB);
        PG8_WAIT_V(6); PG8_BAR;
    }
    for (;;) {
        const bool has_next = S.next(ui + 1, nxt);
        const char* nA = has_next ? (const char*)g.A + (size_t)nxt.pm * tstepA : cA; const char* nB = has_next ? (const char*)g.Bt + (size_t)nxt.pn * tstepB : cB;
#pragma unroll 1
        for (int t = 0; t < nt; t += 2) {
            const bool last = (t == nt - 2);
            const char* a1 = cA + (size_t)(t + 1) * kstep;
            const char* a2 = last ? nA : cA + (size_t)(t + 2) * kstep; const char* b2 = last ? nB : cB + (size_t)(t + 2) * kstep;
            const char* a3 = a2 + kstep; const char* b3 = b2 + kstep;
            if (last && has_next) S.a_ready(nxt);
            if constexpr (SP2) {
            PG8_LDB(B0, 0, 0); PG8_LDB(B1, 0, 1); PG8_SCHED; PG8_LDA(At, 0, 0); PG8_STAGE(PG8_SA(1, 1), a1 + hstepA, voffA);
            PG8_WAIT_V(8); PG8_WAIT_L(0); PG8_BAR; PG8_MMA(0, 0, At, B0); PG8_MMA(0, 1, At, B1); PG8_BAR; PG8_SCHED;
            PG8_LDA(At, 0, 1); PG8_STAGE(PG8_SB(0, 0), b2, voffB); PG8_STAGE(PG8_SB(0, 1), b2 + hstepB, voffB); PG8_STAGE(PG8_SA(0, 0), a2, voffA);
            PG8_WAIT_V(8); PG8_WAIT_L(0); PG8_BAR; PG8_MMA(1, 0, At, B0); PG8_MMA(1, 1, At, B1); PG8_BAR; PG8_SCHED;
            PG8_LDB(B0, 1, 0); PG8_LDB(B1, 1, 1); PG8_SCHED; PG8_LDA(At, 1, 0); PG8_STAGE(PG8_SA(0, 1), a2 + hstepA, voffA);
            PG8_WAIT_V(8); PG8_WAIT_L(0); PG8_BAR; PG8_MMA(0, 0, At, B0); PG8_MMA(0, 1, At, B1); PG8_BAR; PG8_SCHED;
            PG8_LDA(At, 1, 1); PG8_STAGE(PG8_SB(1, 0), b3, voffB); PG8_STAGE(PG8_SB(1, 1), b3 + hstepB, voffB); PG8_STAGE(PG8_SA(1, 0), a3, voffA);
            PG8_WAIT_V(8); PG8_WAIT_L(0); PG8_BAR; PG8_MMA(1, 0, At, B0); PG8_MMA(1, 1, At, B1); PG8_BAR; PG8_SCHED;
            } else {
            PG8_LDB(B0, 0, 0); PG8_SCHED; PG8_LDA(At, 0, 0); PG8_STAGE(PG8_SA(1, 1), a1 + hstepA, voffA);
            PG8_WAIT_L(8); PG8_BAR; PG8_WAIT_L(0); PG8_MMA(0, 0, At, B0); PG8_BAR; PG8_SCHED;
            PG8_LDB(B1, 0, 1); PG8_STAGE(PG8_SB(0, 0), b2, voffB);
            PG8_BAR; PG8_WAIT_L(0); PG8_MMA(0, 1, At, B1); PG8_BAR;
            PG8_LDA(At, 0, 1); PG8_STAGE(PG8_SA(0, 0), a2, voffA);
            PG8_BAR; PG8_WAIT_L(0); PG8_MMA(1, 0, At, B0); PG8_BAR; PG8_SCHED;
            PG8_STAGE(PG8_SB(0, 1), b2 + hstepB, voffB);
            PG8_WAIT_V(6); PG8_BAR; PG8_MMA(1, 1, At, B1); PG8_BAR;
            PG8_LDB(B0, 1, 0); PG8_SCHED; PG8_LDA(At, 1, 0); PG8_STAGE(PG8_SA(0, 1), a2 + hstepA, voffA);
            PG8_WAIT_L(8); PG8_BAR; PG8_WAIT_L(0); PG8_MMA(0, 0, At, B0); PG8_BAR; PG8_SCHED;
            PG8_LDB(B1, 1, 1); PG8_STAGE(PG8_SB(1, 0), b3, voffB);
            PG8_BAR; PG8_WAIT_L(0); PG8_MMA(0, 1, At, B1); PG8_BAR;
            PG8_LDA(At, 1, 1); PG8_STAGE(PG8_SA(1, 0), a3, voffA);
            PG8_BAR; PG8_WAIT_L(0); PG8_MMA(1, 0, At, B0); PG8_BAR; PG8_SCHED;
            PG8_STAGE(PG8_SB(1, 1), b3 + hstepB, voffB);
            PG8_WAIT_V(6); PG8_BAR; PG8_MMA(1, 1, At, B1); PG8_BAR;
            }
        }
        if constexpr (ALIGN_EPI) { if (wr == 0) PG8_BAR; }
        if constexpr (!Epi::AFTER_DRAIN) { E(acc, cur, wr, wc, fr, fq); S.done(cur); }
        if (!has_next) break;
#pragma unroll
        for (int a = 0; a < 2; ++a)
#pragma unroll
            for (int b = 0; b < 2; ++b)
#pragma unroll
                for (int m = 0; m < 4; ++m)
#pragma unroll
                    for (int n = 0; n < 2; ++n) acc[a][b][m][n] = (f32x4){0.f, 0.f, 0.f, 0.f};
        cur = nxt; cA = nA; cB = nB; ++ui;
        if constexpr (ALIGN_EPI) { if (wr == 1) PG8_BAR; }
    }
    PG8_WAIT_V(0);
    if constexpr (!ALIGN_EPI) { if (wr == 0) PG8_BAR; }
    PG8_BAR;
    if constexpr (Epi::AFTER_DRAIN) { E.fused(acc, cur, wr, wc, fr, fq, lds, wid, lane); S.done(cur); }
#undef PG8_SA
#undef PG8_SB
#undef PG8_STAGE
#undef PG8_LDA
#undef PG8_LDB
#undef PG8_MMA
#undef PG8_WAIT_V
#undef PG8_WAIT_L
#undef PG8_BAR
#undef PG8_SCHED
}
}

using pg8::bf16_t; using pg8::bf16x8; using pg8::f32x4; using pg8::u32x4; using pg8::Unit;
typedef unsigned u32x2 __attribute__((ext_vector_type(2)));
typedef float f32x2_t __attribute__((ext_vector_type(2)));
typedef __bf16 bf16x2_t __attribute__((ext_vector_type(2)));
#define LAS __attribute__((address_space(3)))

__device__ __forceinline__ unsigned f2bf(float f) { unsigned u = __builtin_bit_cast(unsigned, f); return (u + 0x7fffu + ((u >> 16) & 1u)) >> 16; }
__device__ __forceinline__ float bf2f(unsigned b) { return __builtin_bit_cast(float, b << 16); }
__device__ __forceinline__ float bflo(unsigned w) { return __builtin_bit_cast(float, w << 16); }
__device__ __forceinline__ float bfhi(unsigned w) { return __builtin_bit_cast(float, w & 0xffff0000u); }
__device__ __forceinline__ unsigned pk2(float lo, float hi) { f32x2_t v = {lo, hi}; bf16x2_t b = __builtin_convertvector(v, bf16x2_t); return __builtin_bit_cast(unsigned, b); }
__device__ __forceinline__ float wave_sum(float v) {
#pragma unroll
    for (int o = 1; o < 64; o <<= 1) v += __shfl_xor(v, o);
    return v;
}
__device__ __forceinline__ float sigmoidf_(float z) { return __builtin_amdgcn_rcpf(1.f + __builtin_amdgcn_exp2f(-z * LOG2E)); }
__device__ __forceinline__ int rope_perm(int p) { return (p >> 4) * 16 + (p & 1) * 8 + ((p & 15) >> 1); }

typedef const f32x4 (&AccRef)[2][2][4][2];
__device__ __forceinline__ void store_bf16_tile(AccRef acc, bf16_t* base, int ldc, int row0, int col0) {
#pragma unroll
    for (int ai = 0; ai < 2; ++ai)
#pragma unroll
        for (int m = 0; m < 4; ++m) { bf16_t* rowp = base + (size_t)(row0 + ai * 128 + m * 16) * ldc + col0;
#pragma unroll
            for (int bj = 0; bj < 2; ++bj) { const f32x4 v0 = acc[ai][bj][m][0], v1 = acc[ai][bj][m][1];
                *(u32x4*)(rowp + bj * 128) = (u32x4){pk2(v0[0], v0[1]), pk2(v0[2], v0[3]), pk2(v1[0], v1[1]), pk2(v1[2], v1[3])}; } }
}
struct EpiG1 {
    static constexpr bool PERM = true, AFTER_DRAIN = false;
    bf16_t *qkv, *lat, *g;
    __device__ __forceinline__ void operator()(AccRef acc, const Unit& u, int wr, int wc, int fr, int fq) const {
        bf16_t* base; int ldc, colt;
        if (u.pn < 6) { base = qkv; ldc = 1536; colt = u.pn * 256; } else if (u.pn < 8) { base = lat; ldc = 512; colt = (u.pn - 6) * 256; } else { base = g; ldc = 2048; colt = (u.pn - 8) * 256; }
        store_bf16_tile(acc, base, ldc, u.pm * 256 + wr * 64 + fr, colt + wc * 32 + 8 * fq);
    }
};
struct EpiPlain {
    static constexpr bool PERM = true, AFTER_DRAIN = false;
    bf16_t* base; int ldc;
    __device__ __forceinline__ void operator()(AccRef acc, const Unit& u, int wr, int wc, int fr, int fq) const { store_bf16_tile(acc, base, ldc, u.pm * 256 + wr * 64 + fr, u.pn * 256 + wc * 32 + 8 * fq); }
};
struct EpiQ {
    static constexpr bool PERM = true, AFTER_DRAIN = false;
    bf16_t* qm; const float* tab;
    __device__ __forceinline__ void operator()(AccRef acc, const Unit& u, int wr, int wc, int fr, int fq) const {
        const float sc = 0.10206207261596577f * LOG2E;
        const int row0 = u.pm * 256 + wr * 64 + fr, colb = u.pn * 256 + wc * 32 + 8 * fq;
#pragma unroll
        for (int bj = 0; bj < 2; ++bj) {
            const int col = colb + bj * 128, d0 = col % 96, pidx0 = d0 - 64, part = pidx0 >> 4, i0 = (pidx0 & 15) >> 1;
#pragma unroll
            for (int ai = 0; ai < 2; ++ai)
#pragma unroll
                for (int m = 0; m < 4; ++m) {
                    const int row = row0 + ai * 128 + m * 16;
                    f32x4 v0 = acc[ai][bj][m][0], v1 = acc[ai][bj][m][1];
                    if (d0 >= 64) {
                        const int t = row & (SEQ - 1), pos = part ? (t & 63) : (t >> 6);
                        const f32x4 c0 = *(const f32x4*)(tab + (pos * 8 + i0) * 2), c1 = *(const f32x4*)(tab + (pos * 8 + i0) * 2 + 4);
                        v0 = (f32x4){v0[0] * c0[0] - v0[1] * c0[1], v0[1] * c0[0] + v0[0] * c0[1], v0[2] * c0[2] - v0[3] * c0[3], v0[3] * c0[2] + v0[2] * c0[3]};
                        v1 = (f32x4){v1[0] * c1[0] - v1[1] * c1[1], v1[1] * c1[0] + v1[0] * c1[1], v1[2] * c1[2] - v1[3] * c1[3], v1[3] * c1[2] + v1[2] * c1[3]};
                    }
                    v0 = v0 * sc; v1 = v1 * sc;
                    *(u32x4*)(qm + (size_t)row * 768 + col) = (u32x4){pk2(v0[0], v0[1]), pk2(v0[2], v0[3]), pk2(v1[0], v1[1]), pk2(v1[2], v1[3])};
                    asm volatile("" ::: "memory");
                }
        }
    }
};
template <bool SECOND> struct EpiGate {
    static constexpr bool PERM = true, AFTER_DRAIN = false;
    bf16_t* mg; const bf16_t* g; const float* bg;
    __device__ __forceinline__ void operator()(AccRef acc, const Unit& u, int wr, int wc, int fr, int fq) const {
        const int row0 = u.pm * 256 + wr * 64 + fr, colb = u.pn * 256 + wc * 32 + 8 * fq, goff = SECOND ? 1024 : 0;
#pragma unroll
        for (int bj = 0; bj < 2; ++bj) {
            const int col = colb + bj * 128;
            const f32x4 b0 = *(const f32x4*)(bg + goff + col), b1 = *(const f32x4*)(bg + goff + col + 4);
#pragma unroll
            for (int ai = 0; ai < 2; ++ai)
#pragma unroll
                for (int m = 0; m < 4; ++m) {
                    const int row = row0 + ai * 128 + m * 16;
                    const u32x4 gv = *(const u32x4*)(g + (size_t)row * 2048 + goff + col);
                    const f32x4 a0 = acc[ai][bj][m][0], a1 = acc[ai][bj][m][1];
                    float o[8];
                    o[0] = sigmoidf_(bflo(gv[0]) + b0[0]) * a0[0]; o[1] = sigmoidf_(bfhi(gv[0]) + b0[1]) * a0[1];
                    o[2] = sigmoidf_(bflo(gv[1]) + b0[2]) * a0[2]; o[3] = sigmoidf_(bfhi(gv[1]) + b0[3]) * a0[3];
                    o[4] = sigmoidf_(bflo(gv[2]) + b1[0]) * a1[0]; o[5] = sigmoidf_(bfhi(gv[2]) + b1[1]) * a1[1];
                    o[6] = sigmoidf_(bflo(gv[3]) + b1[2]) * a1[2]; o[7] = sigmoidf_(bfhi(gv[3]) + b1[3]) * a1[3];
                    u32x4* dst = (u32x4*)(mg + (size_t)row * DM + col);
                    if (SECOND) { const u32x4 old = *dst;
#pragma unroll
                        for (int e = 0; e < 4; ++e) { o[2 * e] += bflo(old[e]); o[2 * e + 1] += bfhi(old[e]); } }
                    *dst = (u32x4){pk2(o[0], o[1]), pk2(o[2], o[3]), pk2(o[4], o[5]), pk2(o[6], o[7])};
                }
        }
    }
};
struct EpiRes {
    static constexpr bool PERM = false, AFTER_DRAIN = false;
    const float* base; float* y;
    __device__ __forceinline__ void operator()(AccRef acc, const Unit& u, int wr, int wc, int fr, int fq) const {
#pragma unroll
        for (int ai = 0; ai < 2; ++ai)
#pragma unroll
            for (int m = 0; m < 4; ++m) { const size_t roff = (size_t)(u.pm * 256 + ai * 128 + wr * 64 + m * 16 + fr) * DM + u.pn * 256 + wc * 32 + 4 * fq;
#pragma unroll
                for (int bj = 0; bj < 2; ++bj)
#pragma unroll
                    for (int n = 0; n < 2; ++n) { const size_t off = roff + bj * 128 + n * 16; const f32x4 b = *(const f32x4*)(base + off); *(f32x4*)(y + off) = b * DN_ALPHA + acc[ai][bj][m][n]; } }
    }
};
struct EpiSwiglu {
    static constexpr bool PERM = true, AFTER_DRAIN = false;
    bf16_t* hid;
    __device__ __forceinline__ void operator()(AccRef acc, const Unit& u, int wr, int wc, int fr, int fq) const {
        const int row0 = u.pm * 256 + wr * 64 + fr, col = u.pn * 128 + wc * 32 + 8 * fq;
#pragma unroll
        for (int ai = 0; ai < 2; ++ai)
#pragma unroll
            for (int m = 0; m < 4; ++m) {
                const f32x4 g0 = acc[ai][0][m][0], g1 = acc[ai][0][m][1], u0 = acc[ai][1][m][0], u1 = acc[ai][1][m][1];
                float o[8];
#pragma unroll
                for (int e = 0; e < 4; ++e) { o[e] = g0[e] * sigmoidf_(g0[e]) * u0[e]; o[4 + e] = g1[e] * sigmoidf_(g1[e]) * u1[e]; }
                *(u32x4*)(hid + (size_t)(row0 + ai * 128 + m * 16) * FFH + col) = (u32x4){pk2(o[0], o[1]), pk2(o[2], o[3]), pk2(o[4], o[5]), pk2(o[6], o[7])};
            }
    }
};

__device__ __forceinline__ int colmap(int mode, int n) {
    if (mode == 1) {
        if (n < 1920) return n;
        if (n < 1952) return 1920 + rope_perm(n - 1920);
        if (n < 2048) return -1;
        return n - 96;
    }
    if (mode == 2) {
        const int h = n / 96, d = n % 96;
        return d < 64 ? n : h * 96 + 64 + rope_perm(d - 64);
    }
    if (mode == 3) {
        const int t = n >> 8, w = n & 255;
        return w < 128 ? 128 * t + w : FFH + 128 * t + (w - 128);
    }
    return n;
}
__device__ void transpose_w(const float* __restrict__ W, int K, int Nsrc, bf16_t* __restrict__ Wt, int ldk, int Ndst, int mode, float* tile, int bid, int nb) {
    const int tid = threadIdx.x, nw = blockDim.x >> 6, nkt = K / 64, nnt = Ndst / 64;
    for (int t = bid; t < nkt * nnt; t += nb) {
        const int kt = t / nnt, nt = t % nnt;
        const int n = nt * 64 + (tid & 63), src = colmap(mode, n);
        for (int kl = tid >> 6; kl < 64; kl += nw) tile[kl * 65 + (tid & 63)] = src >= 0 ? W[(size_t)(kt * 64 + kl) * Nsrc + src] : 0.f;
        __syncthreads();
        for (int nl = tid >> 6; nl < 64; nl += nw) Wt[(size_t)(nt * 64 + nl) * ldk + kt * 64 + (tid & 63)] = (bf16_t)f2bf(tile[(tid & 63) * 65 + nl]);
        __syncthreads();
    }
}
__device__ void stage0(const Params& p, float* smem, int bid, int nb) {
    unsigned char* ws = p.ws;
    transpose_w(p.w_in, DM, 4000, (bf16_t*)(ws + WS_WIN), DM, HP, 1, smem, bid, nb);
    transpose_w(p.w_uq, QLORA, MH * QK, (bf16_t*)(ws + WS_WUQ), QLORA, MH * QK, 2, smem, bid, nb);
    transpose_w(p.w_ukv, KVLORA, 1024, (bf16_t*)(ws + WS_WUKV), 256, 1024, 0, smem, bid, nb);
    transpose_w(p.w_bna, 512, DM, (bf16_t*)(ws + WS_WBNA), 512, DM, 0, smem, bid, nb);
    transpose_w(p.w_bmla, 512, DM, (bf16_t*)(ws + WS_WBMLA), 512, DM, 0, smem, bid, nb);
    transpose_w(p.w_out, DM, DM, (bf16_t*)(ws + WS_WOUT), DM, DM, 0, smem, bid, nb);
    transpose_w(p.w_fi, DM, 2 * FFH, (bf16_t*)(ws + WS_WFI), DM, 2 * FFH, 3, smem, bid, nb);
    transpose_w(p.w_fo, FFH, DM, (bf16_t*)(ws + WS_WFO), FFH, DM, 0, smem, bid, nb);
    {
        bf16_t* wt = (bf16_t*)(ws + WS_WUKV);
        for (int i = bid * blockDim.x + threadIdx.x; i < 1024 * 16; i += nb * blockDim.x) { const int n = i >> 4, c = i & 15; *(u32x4*)(wt + (size_t)n * 256 + 128 + 8 * c) = (u32x4){0u, 0u, 0u, 0u}; }
    }
    const f32x4* xs = (const f32x4*)p.x; u32x4* xd = (u32x4*)(ws + WS_XB);
    for (size_t i = (size_t)bid * blockDim.x + threadIdx.x; i < (size_t)M * DM / 8; i += (size_t)nb * blockDim.x) {
        const f32x4 a = xs[2 * i], b = xs[2 * i + 1];
        xd[i] = (u32x4){pk2(a[0], a[1]), pk2(a[2], a[3]), pk2(b[0], b[1]), pk2(b[2], b[3])};
    }
    if (bid == 0) {
        float2* tab = (float2*)(ws + WS_ROPE);
        for (int e = threadIdx.x; e < 64 * 8; e += blockDim.x) {
            const int pos = e >> 3, i = e & 7;
            const float inv = __builtin_amdgcn_exp2f(-(float)i * 0.125f * 13.287712379549449f);
            const float rev = (float)pos * inv * 0.15915494309189535f;
            tab[e] = make_float2(__builtin_amdgcn_cosf(rev), __builtin_amdgcn_sinf(rev));
        }
    }
}

__device__ void stage_lat(const Params& p, int bid, int nb) {
    const int lane = threadIdx.x & 63, gw = bid * (blockDim.x >> 6) + (threadIdx.x >> 6), ngw = nb * (blockDim.x >> 6);
    bf16_t* lat = (bf16_t*)(p.ws + WS_LAT); bf16_t* kpe = (bf16_t*)(p.ws + WS_KPE);
    const float2* tab = (const float2*)(p.ws + WS_ROPE);
    for (int row = gw; row < M; row += ngw) {
        bf16_t* lr = lat + (size_t)row * 512;
        {
            const u32x2 v = *(const u32x2*)(lr + 4 * lane);
            const float a0 = bflo(v.x), a1 = bfhi(v.x), a2 = bflo(v.y), a3 = bfhi(v.y);
            const float rs = rsqrtf(wave_sum(a0 * a0 + a1 * a1 + a2 * a2 + a3 * a3) * (1.f / 256.f) + RMS_EPS);
            const f32x4 g = *(const f32x4*)(p.qn + 4 * lane);
            *(u32x2*)(lr + 4 * lane) = (u32x2){pk2(a0 * rs * g[0], a1 * rs * g[1]), pk2(a2 * rs * g[2], a3 * rs * g[3])};
        }
        {
            const unsigned v = *(const unsigned*)(lr + 256 + 2 * lane);
            const float a0 = bflo(v), a1 = bfhi(v);
            const float rs = rsqrtf(wave_sum(a0 * a0 + a1 * a1) * (1.f / 128.f) + RMS_EPS);
            *(unsigned*)(lr + 256 + 2 * lane) = pk2(a0 * rs * p.kvn[2 * lane], a1 * rs * p.kvn[2 * lane + 1]);
        }
        {
            const int pidx = lane & 31, part = pidx >> 4, i = (pidx & 15) >> 1, odd = pidx & 1;
            const float v = bf2f(lr[384 + pidx]);
            const int t = row & (SEQ - 1), pos = part ? (t & 63) : (t >> 6);
            const float2 cs = tab[pos * 8 + i];
            const float partner = __shfl_xor(v, 1);
            const float o = v * cs.x + (odd ? partner : -partner) * cs.y;
            if (lane < 32) kpe[(size_t)row * 32 + pidx] = (bf16_t)f2bf(o);
        }
    }
}

__device__ void stage_na(const Params& p, int bid, int nb) {
    const bf16_t* qkv = (const bf16_t*)(p.ws + WS_QKV); bf16_t* ao = (bf16_t*)(p.ws + WS_AO);
    for (int idx = bid * blockDim.x + threadIdx.x; idx < M * NAH; idx += nb * blockDim.x) {
        const int token = idx % M, h = idx / M;
        const int b = token / SEQ, t = token % SEQ, r = t / GRIDW, c = t % GRIDW;
        int rs = r - 4; rs = rs < 0 ? 0 : (rs > 56 ? 56 : rs);
        int cs = c - 8; cs = cs < 0 ? 0 : (cs > 48 ? 48 : cs);
        float q[64], o[64];
        const bf16_t* qp = qkv + (size_t)token * 1536 + h * 64;
#pragma unroll
        for (int d8 = 0; d8 < 8; ++d8) { const u32x4 v = *(const u32x4*)(qp + 8 * d8);
#pragma unroll
            for (int e = 0; e < 4; ++e) { q[8 * d8 + 2 * e] = bflo(v[e]) * (0.125f * LOG2E); q[8 * d8 + 2 * e + 1] = bfhi(v[e]) * (0.125f * LOG2E); } }
#pragma unroll
        for (int d = 0; d < 64; ++d) o[d] = 0.f;
        float m = -INFINITY, l = 0.f;
        for (int i = 0; i < 8; ++i)
            for (int j = 0; j < 16; ++j) {
                const size_t kt = (size_t)b * SEQ + (rs + i) * GRIDW + cs + j;
                const bf16_t* kp = qkv + kt * 1536 + 512 + h * 64; const bf16_t* vp = kp + 512;
                float s = 0.f;
#pragma unroll
                for (int d8 = 0; d8 < 8; ++d8) { const u32x4 v = *(const u32x4*)(kp + 8 * d8);
#pragma unroll
                    for (int e = 0; e < 4; ++e) { s += q[8 * d8 + 2 * e] * bflo(v[e]); s += q[8 * d8 + 2 * e + 1] * bfhi(v[e]); } }
                s += p.rpb[(h * 15 + (rs + i - r + 7)) * 31 + (cs + j - c + 15)] * LOG2E;
                const float mn = fmaxf(m, s), alpha = __builtin_amdgcn_exp2f(m - mn), pe = __builtin_amdgcn_exp2f(s - mn);
                l = l * alpha + pe; m = mn;
#pragma unroll
                for (int d8 = 0; d8 < 8; ++d8) { const u32x4 v = *(const u32x4*)(vp + 8 * d8);
#pragma unroll
                    for (int e = 0; e < 4; ++e) { o[8 * d8 + 2 * e] = o[8 * d8 + 2 * e] * alpha + pe * bflo(v[e]); o[8 * d8 + 2 * e + 1] = o[8 * d8 + 2 * e + 1] * alpha + pe * bfhi(v[e]); } }
            }
        const float il = 1.f / l;
        bf16_t* op = ao + (size_t)token * 1024 + h * 64;
#pragma unroll
        for (int d8 = 0; d8 < 8; ++d8) *(u32x4*)(op + 8 * d8) = (u32x4){pk2(o[8 * d8] * il, o[8 * d8 + 1] * il), pk2(o[8 * d8 + 2] * il, o[8 * d8 + 3] * il), pk2(o[8 * d8 + 4] * il, o[8 * d8 + 5] * il), pk2(o[8 * d8 + 6] * il, o[8 * d8 + 7] * il)};
    }
}

namespace mla {
typedef float f32x16 __attribute__((ext_vector_type(16)));
typedef short s16x4 __attribute__((ext_vector_type(4)));
typedef short v4i16_t __attribute__((ext_vector_type(4)));
typedef LAS const char* lds_cptr;
constexpr int KSLOT = 12288, VSLOT = 8192, NSLOT = 3, NT = SEQ / 64;
constexpr int L_K = 0, L_V = NSLOT * KSLOT, L_WS = L_V + NSLOT * VSLOT, L_OST = L_WS + 8 * 64 * 4, L_END = L_OST + 8 * 4096;
constexpr float THR = 5.0f;
__device__ __forceinline__ int crow(int r, int hi) { return (r & 3) + 8 * (r >> 2) + 4 * hi; }
__device__ __forceinline__ void glds16(const void* gsrc, unsigned lds_dst) { unsigned keep;
    asm volatile("s_mov_b32 %0, m0\n\ts_mov_b32 m0, %2\n\ts_nop 0\n\tglobal_load_lds_dwordx4 %1, off\n\ts_mov_b32 m0, %0" : "=&s"(keep) : "v"(gsrc), "s"(lds_dst) : "memory"); }
__device__ __forceinline__ s16x4 vtr(lds_cptr p) { return __builtin_bit_cast(s16x4, __builtin_amdgcn_ds_read_tr16_b64_v4i16((LAS v4i16_t*)p)); }
#define MLA_WAIT_BAR(N) asm volatile("s_waitcnt vmcnt(" #N ") lgkmcnt(0)\n\ts_barrier" ::: "memory")

__device__ __forceinline__ void unit(int b, int h, int qb, const bf16_t* __restrict__ QM, const bf16_t* __restrict__ KVM, const bf16_t* __restrict__ KPE, bf16_t* __restrict__ AO, unsigned char* shm) {
    const int tid = threadIdx.x, lane = tid & 63, r32 = lane & 31, hi = lane >> 5; const int wid = __builtin_amdgcn_readfirstlane(tid >> 6);
    const size_t rowbase = (size_t)b * SEQ; const int q0 = qb * 256;
    const unsigned lds0 = (unsigned)(uintptr_t)shm;
    const lds_cptr shm3 = (lds_cptr)shm;
    LAS float* wsf = (LAS float*)(shm3 + L_WS) + wid * 64;
    const bf16_t* ksrc = KVM + (rowbase + lane) * 1024 + h * 128 + wid * 8;
    const bf16_t* psrc = KPE + (rowbase + lane) * 32 + (wid & 3) * 8;
    const bf16_t* vsrc = KVM + (rowbase + 16 * (wid & 3) + (lane >> 2)) * 1024 + h * 128 + 64 + (wid >> 2) * 32 + (lane & 3) * 8;
    const unsigned kdst = lds0 + L_K + wid * 1024, pdst = lds0 + L_K + (8 + (wid & 3)) * 1024, vdst = lds0 + L_V + wid * 1024;
#define MLA_DMA(t, s) do { glds16(ksrc + (size_t)(t) * 64 * 1024, (unsigned)__builtin_amdgcn_readfirstlane(kdst + (s) * KSLOT)); \
        if (wid < 4) glds16(psrc + (size_t)(t) * 64 * 32, (unsigned)__builtin_amdgcn_readfirstlane(pdst + (s) * KSLOT)); \
        glds16(vsrc + (size_t)(t) * 64 * 1024, (unsigned)__builtin_amdgcn_readfirstlane(vdst + (s) * VSLOT)); } while (0)
    MLA_DMA(0, 0); MLA_DMA(1, 1);
    bf16x8 qr[6];
    { const bf16_t* qp = QM + (rowbase + q0 + wid * 32 + r32) * 768 + h * 96 + hi * 8;
#pragma unroll
      for (int d0 = 0; d0 < 6; ++d0) qr[d0] = *(const bf16x8*)(qp + d0 * 16); }
    float m = -INFINITY, l = 0.f; f32x16 o0 = {}, o1 = {};
    const lds_cptr kp0 = shm3 + L_K + hi * 1024 + r32 * 16;
    const lds_cptr vp0 = shm3 + L_V + ((lane >> 4) & 1) * 32 + (lane & 3) * 8 + (4 * hi + ((lane & 15) >> 2)) * 64;
    int slot = 0;
    for (int t = 0; t < NT; ++t) {
        if (t + 1 < NT) { if (wid < 4) MLA_WAIT_BAR(3); else MLA_WAIT_BAR(2); } else MLA_WAIT_BAR(0);
        if (t + 2 < NT) { const int s2 = slot == 0 ? 2 : slot - 1; MLA_DMA(t + 2, s2); }
        const lds_cptr kp = kp0 + slot * KSLOT; const lds_cptr vp = vp0 + slot * VSLOT;
        f32x16 p0 = {}, p1 = {};
#pragma unroll
        for (int d0 = 0; d0 < 6; ++d0) {
            const bf16x8 k0 = *(const LAS bf16x8*)(kp + d0 * 2048), k1 = *(const LAS bf16x8*)(kp + d0 * 2048 + 512);
            p0 = __builtin_amdgcn_mfma_f32_32x32x16_bf16(k0, qr[d0], p0, 0, 0, 0);
            p1 = __builtin_amdgcn_mfma_f32_32x32x16_bf16(k1, qr[d0], p1, 0, 0, 0);
        }
        float rm = fmaxf(p0[0], p1[0]);
#pragma unroll
        for (int r = 1; r < 16; ++r) rm = fmaxf(rm, fmaxf(p0[r], p1[r]));
        { auto rr = __builtin_amdgcn_permlane32_swap(__float_as_uint(rm), __float_as_uint(rm), false, false); rm = fmaxf(__uint_as_float(rr[0]), __uint_as_float(rr[1])); }
        if (__any(rm > m + THR)) {
            const float mn = fmaxf(m, rm), f = __builtin_amdgcn_exp2f(m - mn);
            m = mn; l *= f;
            if (hi == 0) wsf[r32] = f;
            asm volatile("s_waitcnt lgkmcnt(0)" ::: "memory");
#pragma unroll
            for (int r = 0; r < 16; ++r) { const float fr_ = wsf[crow(r, hi)]; o0[r] *= fr_; o1[r] *= fr_; }
        }
        float sacc = 0.f;
#pragma unroll
        for (int r = 0; r < 16; ++r) { p0[r] = __builtin_amdgcn_exp2f(p0[r] - m); p1[r] = __builtin_amdgcn_exp2f(p1[r] - m); sacc += p0[r] + p1[r]; }
        l += sacc;
        const u32x4 pw0 = {pk2(p0[0], p0[1]), pk2(p0[2], p0[3]), pk2(p0[4], p0[5]), pk2(p0[6], p0[7])};
        const u32x4 pw1 = {pk2(p0[8], p0[9]), pk2(p0[10], p0[11]), pk2(p0[12], p0[13]), pk2(p0[14], p0[15])};
        const u32x4 pw2 = {pk2(p1[0], p1[1]), pk2(p1[2], p1[3]), pk2(p1[4], p1[5]), pk2(p1[6], p1[7])};
        const u32x4 pw3 = {pk2(p1[8], p1[9]), pk2(p1[10], p1[11]), pk2(p1[12], p1[13]), pk2(p1[14], p1[15])};
#define MLA_PV(O, D0, KS, PW) do { const s16x4 lo_ = vtr(vp + ((D0) * 4096 + (KS) * 1024)), hi_ = vtr(vp + ((D0) * 4096 + (KS) * 1024 + 512)); \
        const bf16x8 vf_ = {lo_[0], lo_[1], lo_[2], lo_[3], hi_[0], hi_[1], hi_[2], hi_[3]}; \
        O = __builtin_amdgcn_mfma_f32_32x32x16_bf16(__builtin_bit_cast(bf16x8, PW), vf_, O, 0, 0, 0); } while (0)
        MLA_PV(o0, 0, 0, pw0); MLA_PV(o1, 1, 0, pw0); MLA_PV(o0, 0, 1, pw1); MLA_PV(o1, 1, 1, pw1);
        MLA_PV(o0, 0, 2, pw2); MLA_PV(o1, 1, 2, pw2); MLA_PV(o0, 0, 3, pw3); MLA_PV(o1, 1, 3, pw3);
#undef MLA_PV
        slot = slot == 2 ? 0 : slot + 1;
    }
    { auto rr = __builtin_amdgcn_permlane32_swap(__float_as_uint(l), __float_as_uint(l), false, false); l = __uint_as_float(rr[0]) + __uint_as_float(rr[1]); }
    if (hi == 0) wsf[32 + r32] = l;
    asm volatile("s_waitcnt lgkmcnt(0)" ::: "memory");
    LAS bf16_t* stg = (LAS bf16_t*)(shm3 + L_OST) + wid * 2048;
#pragma unroll
    for (int r = 0; r < 16; ++r) { const int orow = crow(r, hi); const float il = __builtin_amdgcn_rcpf(wsf[32 + orow]);
        stg[orow * 64 + r32] = (bf16_t)f2bf(o0[r] * il); stg[orow * 64 + 32 + r32] = (bf16_t)f2bf(o1[r] * il); }
    asm volatile("s_waitcnt lgkmcnt(0)" ::: "memory");
    bf16_t* Ow = AO + (rowbase + q0 + wid * 32) * 1024 + 512 + h * 64;
#pragma unroll
    for (int i = 0; i < 4; ++i) { const int row = i * 8 + (lane >> 3), ch = lane & 7; const u32x4 v = *(const LAS u32x4*)(stg + row * 64 + ch * 8); *(u32x4*)(Ow + (size_t)row * 1024 + ch * 8) = v; }
    asm volatile("s_waitcnt lgkmcnt(0)\n\ts_barrier" ::: "memory");
#undef MLA_DMA
}
__device__ __forceinline__ void phase(const Params& p, unsigned char* shm, int bid, int nb) {
    const int vcu = (nb % 8 == 0) ? (bid % 8) * (nb / 8) + bid / 8 : bid;
    const bf16_t* qm = (const bf16_t*)(p.ws + WS_QM); const bf16_t* kvm = (const bf16_t*)(p.ws + WS_KVM); const bf16_t* kpe = (const bf16_t*)(p.ws + WS_KPE); bf16_t* ao = (bf16_t*)(p.ws + WS_AO);
    const int nunits = 4 * 8 * 16, per = (nunits + nb - 1) / nb;
    for (int i = 0; i < per; ++i) { const int u = vcu * per + i; if (u >= nunits) break;
        unit(u / 128, (u / 16) % 8, u % 16, qm, kvm, kpe, ao, shm); }
}
#undef MLA_WAIT_BAR
}

__device__ void stage_ln(float* y, const float* __restrict__ g, const float* __restrict__ bta, bf16_t* ob, int bid, int nb) {
    const int lane = threadIdx.x & 63, gw = bid * (blockDim.x >> 6) + (threadIdx.x >> 6), ngw = nb * (blockDim.x >> 6);
    for (int row = gw; row < M; row += ngw) {
        f32x4* yr = (f32x4*)(y + (size_t)row * DM) + lane;
        f32x4 v[4]; float s = 0.f;
#pragma unroll
        for (int j = 0; j < 4; ++j) { v[j] = yr[64 * j]; s += (v[j][0] + v[j][1]) + (v[j][2] + v[j][3]); }
        const float mean = wave_sum(s) * (1.f / DM); float s2 = 0.f;
#pragma unroll
        for (int j = 0; j < 4; ++j) { v[j] = v[j] - mean; s2 += (v[j][0] * v[j][0] + v[j][1] * v[j][1]) + (v[j][2] * v[j][2] + v[j][3] * v[j][3]); }
        const float rstd = rsqrtf(wave_sum(s2) * (1.f / DM) + LN_EPS);
#pragma unroll
        for (int j = 0; j < 4; ++j) {
            const f32x4 gg = ((const f32x4*)g)[lane + 64 * j], bb = ((const f32x4*)bta)[lane + 64 * j];
            const f32x4 o = v[j] * rstd * gg + bb;
            yr[64 * j] = o;
            if (ob) *(u32x2*)(ob + (size_t)row * DM + 4 * (lane + 64 * j)) = (u32x2){pk2(o[0], o[1]), pk2(o[2], o[3])};
        }
    }
}

constexpr int NPHASE = 12;
constexpr int LDS_BYTES = 132 * 1024;
__global__ void __launch_bounds__(NTHREADS, 2) fwd_megakernel(Params p) {
    extern __shared__ __attribute__((aligned(16))) unsigned char lds[];
    cg::grid_group grid = cg::this_grid();
    const int bid = blockIdx.x, nb = gridDim.x;
    LAS unsigned char* ring = (LAS unsigned char*)lds;
    float* smem = (float*)lds;
    unsigned char* ws = p.ws;
#define IN(k) (p.ph_lo <= (k) && (k) < p.ph_hi)
#define SEAM(k) do { if (IN(k) && IN((k) + 1)) grid.sync(); } while (0)
#define BF(off) ((bf16_t*)(ws + (off)))
    typedef pg8::StaticOrder SO;
    if (IN(0)) stage0(p, smem, bid, nb);
    SEAM(0);
    if (IN(1)) { pg8::Gemm g{BF(WS_XB), BF(WS_WIN), M, HP, DM, DM, DM}; SO S; S.init(M, HP, nb, bid); EpiG1 E{BF(WS_QKV), BF(WS_LAT), BF(WS_G)};
        pg8::gemm_phase<EpiG1, SO, true, true>(ring, g, S, E); }
    SEAM(1);
    if (IN(2)) stage_lat(p, bid, nb);
    SEAM(2);
    if (IN(3)) {
        { pg8::Gemm g{BF(WS_LAT) + 256, BF(WS_WUKV), M, 1024, 256, 512, 256}; SO S; S.init(M, 1024, nb, bid); EpiPlain E{BF(WS_KVM), 1024};
          pg8::gemm_phase<EpiPlain, SO, true, true>(ring, g, S, E); }
        { pg8::Gemm g{BF(WS_LAT), BF(WS_WUQ), M, 768, 256, 512, 256}; SO S; S.init(M, 768, nb, (bid + 64) % nb); EpiQ E{BF(WS_QM), (const float*)(ws + WS_ROPE)};
          pg8::gemm_phase<EpiQ, SO, true, true>(ring, g, S, E); }
    }
    SEAM(3);
    if (IN(4)) { stage_na(p, bid, nb); __syncthreads(); mla::phase(p, lds, bid, nb); }
    SEAM(4);
    if (IN(5)) { pg8::Gemm g{BF(WS_AO), BF(WS_WBNA), M, DM, 512, 1024, 512}; SO S; S.init(M, DM, nb, bid); EpiGate<false> E{BF(WS_MG), BF(WS_G), p.b_gate};
        pg8::gemm_phase<EpiGate<false>, SO, true, true>(ring, g, S, E); }
    SEAM(5);
    if (IN(6)) { pg8::Gemm g{BF(WS_AO) + 512, BF(WS_WBMLA), M, DM, 512, 1024, 512}; SO S; S.init(M, DM, nb, bid); EpiGate<true> E{BF(WS_MG), BF(WS_G), p.b_gate};
        pg8::gemm_phase<EpiGate<true>, SO, true, true>(ring, g, S, E); }
    SEAM(6);
    if (IN(7)) { pg8::Gemm g{BF(WS_MG), BF(WS_WOUT), M, DM, DM, DM, DM}; SO S; S.init(M, DM, nb, bid); EpiRes E{p.x, p.out};
        pg8::gemm_phase<EpiRes, SO, true, true>(ring, g, S, E); }
    SEAM(7);
    if (IN(8)) stage_ln(p.out, p.ln1g, p.ln1b, BF(WS_X1B), bid, nb);
    SEAM(8);
    if (IN(9)) { pg8::Gemm g{BF(WS_X1B), BF(WS_WFI), M, 2 * FFH, DM, DM, DM}; SO S; S.init(M, 2 * FFH, nb, bid); EpiSwiglu E{BF(WS_HID)};
        pg8::gemm_phase<EpiSwiglu, SO, true, true>(ring, g, S, E); }
    SEAM(9);
    if (IN(10)) { pg8::Gemm g{BF(WS_HID), BF(WS_WFO), M, DM, FFH, FFH, FFH}; SO S; S.init(M, DM, nb, bid); EpiRes E{p.out, p.out};
        pg8::gemm_phase<EpiRes, SO, true, true>(ring, g, S, E); }
    SEAM(10);
    if (IN(11)) stage_ln(p.out, p.ln2g, p.ln2b, nullptr, bid, nb);
#undef IN
#undef SEAM
#undef BF
}

extern "C" void kernel_launch(void* const* d_in, const int* in_sizes, int n_in, void* d_out, int out_size, void* d_ws, size_t ws_size, hipStream_t stream) {
    if (n_in != 17 || out_size != M * DM || ws_size < WS_END) { fprintf(stderr, "kernel_launch: unexpected shapes (n_in %d, out %d, ws %zu)\n", n_in, out_size, ws_size); return; }
    Params p{};
    p.x = (const float*)d_in[0]; p.w_in = (const float*)d_in[1]; p.b_gate = (const float*)d_in[2]; p.rpb = (const float*)d_in[3]; p.qn = (const float*)d_in[4];
    p.w_uq = (const float*)d_in[5]; p.kvn = (const float*)d_in[6]; p.w_ukv = (const float*)d_in[7]; p.w_bna = (const float*)d_in[8]; p.w_bmla = (const float*)d_in[9];
    p.w_out = (const float*)d_in[10]; p.ln1g = (const float*)d_in[11]; p.ln1b = (const float*)d_in[12]; p.w_fi = (const float*)d_in[13]; p.w_fo = (const float*)d_in[14];
    p.ln2g = (const float*)d_in[15]; p.ln2b = (const float*)d_in[16];
    p.out = (float*)d_out; p.ws = (unsigned char*)d_ws;
    static int grid_blocks = 0;
    if (!grid_blocks) {
        int dev = 0, cus = 0, per_cu = 0;
        hipGetDevice(&dev);
        hipDeviceGetAttribute(&cus, hipDeviceAttributeMultiprocessorCount, dev);
        hipFuncSetAttribute((const void*)fwd_megakernel, hipFuncAttributeMaxDynamicSharedMemorySize, LDS_BYTES);
        hipOccupancyMaxActiveBlocksPerMultiprocessor(&per_cu, (const void*)fwd_megakernel, NTHREADS, LDS_BYTES);
        if (per_cu < 1) per_cu = 1;
        grid_blocks = cus * per_cu;
    }
#if FUSED
    p.ph_lo = 0; p.ph_hi = NPHASE;
    void* args[] = {&p};
    hipError_t e = hipLaunchCooperativeKernel((const void*)fwd_megakernel, dim3(grid_blocks), dim3(NTHREADS), args, LDS_BYTES, stream);
    if (e != hipSuccess) fprintf(stderr, "cooperative launch failed: %s (grid %d)\n", hipGetErrorString(e), grid_blocks);
#else
    for (int ph = 0; ph < NPHASE; ++ph) { p.ph_lo = ph; p.ph_hi = ph + 1; hipLaunchKernelGGL(fwd_megakernel, dim3(grid_blocks), dim3(NTHREADS), LDS_BYTES, stream, p); }
#endif
}
```

```cpp
#include <hip/hip_runtime.h>
#include <hip/hip_cooperative_groups.h>
#include <cstdint>
#include <cstdio>
namespace cg = cooperative_groups;

#ifndef FUSED
#define FUSED 1
#endif
#ifndef PROBE_SC_NA
#define PROBE_SC_NA 1.0f
#endif
#ifndef PROBE_SC_MLA
#define PROBE_SC_MLA 1.0f
#endif
#ifndef PROBE_NOROPE
#define PROBE_NOROPE 0
#endif
#ifndef PROBE_F32G1
#define PROBE_F32G1 0
#endif
#ifndef PROBE_F64LN
#define PROBE_F64LN 0
#endif
#ifndef PROBE_XBITS
#define PROBE_XBITS 0
#endif
#ifndef REP
#define REP 0
#endif
#ifndef PROBE_ZERO
#define PROBE_ZERO 0
#endif
#ifndef PROBE_F32FFN
#define PROBE_F32FFN 0
#endif

constexpr int M = 16384, DM = 1024, SEQ = 4096, GRIDW = 64;
constexpr int NAH = 8;
constexpr int QLORA = 256, KVLORA = 128, QK = 96, MH = 8;
constexpr int FFH = 2816;
constexpr int HP = 4096;
constexpr float LOG2E = 1.4426950408889634f;
constexpr float DN_ALPHA = 1.189207115002721f;
constexpr float LN_EPS = 1e-5f, RMS_EPS = 1e-6f;
constexpr int NTHREADS = 512;

constexpr size_t MiB = 1u << 20;
constexpr size_t WS_ROPE = 64 * 1024;
constexpr size_t WS_WIN = 1 * MiB;
constexpr size_t WS_WUQ = 9 * MiB;
constexpr size_t WS_WUKV = 9 * MiB + 512 * 1024;
constexpr size_t WS_WBNA = 10 * MiB;
constexpr size_t WS_WBMLA = 11 * MiB;
constexpr size_t WS_WOUT = 12 * MiB;
constexpr size_t WS_WFI = 14 * MiB;
constexpr size_t WS_WFO = 25 * MiB;
constexpr size_t WS_XB = 32 * MiB;
constexpr size_t WS_QM = 32 * MiB;
constexpr size_t WS_KPE = 56 * MiB;
constexpr size_t WS_MG = 32 * MiB;
constexpr size_t WS_QKV = 64 * MiB;
constexpr size_t WS_X1B = 64 * MiB;
constexpr size_t WS_LAT = 112 * MiB;
constexpr size_t WS_G = 128 * MiB;
constexpr size_t WS_HID = 128 * MiB;
constexpr size_t WS_KVM = 192 * MiB;
constexpr size_t WS_AO = 224 * MiB;
constexpr size_t WS_END = 256 * MiB;

struct Params {
    const float *x, *w_in, *b_gate, *rpb, *qn, *w_uq, *kvn, *w_ukv, *w_bna, *w_bmla, *w_out, *ln1g, *ln1b, *w_fi, *w_fo, *ln2g, *ln2b;
    float* out; unsigned char* ws; int ph_lo, ph_hi;
};

namespace pg8 {
#define PG8_LAS __attribute__((address_space(3)))
typedef unsigned short bf16_t;
typedef short bf16x8 __attribute__((ext_vector_type(8)));
typedef float f32x4 __attribute__((ext_vector_type(4)));
typedef unsigned u32x4 __attribute__((ext_vector_type(4)));
constexpr int BM = 256, BK = 64, HALF = 128, HTB = HALF * BK * 2  , STAGE_BYTES = 8 * HTB, NXCD = 8, WGM = 8;

__host__ __device__ __forceinline__ int lds_byte(int r, int c) { const int st = (r >> 4) * 2 + (c >> 5), rr = r & 15, cc = c & 31, ob = rr * 64 + cc * 2; return st * 1024 + (ob ^ (((ob >> 9) & 1) << 5)); }
__host__ __device__ __forceinline__ void stage_rc(int b, int& R, int& C) { const int st = b / 1024, sb = b % 1024, swz = sb ^ (((sb >> 9) & 1) << 5); R = (st >> 1) * 16 + swz / 64; C = (st & 1) * 32 + (swz % 64) / 2; }
__host__ __device__ __forceinline__ int perm32(int rho) { const int n = rho >> 4, i = rho & 15; return 8 * (i >> 2) + 4 * n + (i & 3); }

struct Unit { int pm, pn; };
struct Gemm { const bf16_t* A; const bf16_t* Bt; int M, N, K, lda, ldb; };

struct StaticOrder {
    int nM, nN, nwg, G, c;
    __host__ __device__ void init(int M, int N, int G_, int c_) { nM = M / BM; nN = N / BM; nwg = nM * nN; G = G_; c = c_; }
    __host__ __device__ bool next(int i, Unit& u) const {
        const long L = (long)i * G + c; if (L >= nwg) return false;
        int wgid = (int)L; { const int q = nwg / NXCD, r = nwg % NXCD, xcd = wgid % NXCD, off = wgid / NXCD; wgid = (xcd < r ? xcd * (q + 1) : r * (q + 1) + (xcd - r) * q) + off; }
        const int nig = WGM * nN, gid = wgid / nig, fm = gid * WGM, gsz = (nM - fm) < WGM ? (nM - fm) : WGM;
        u.pm = fm + ((wgid % nig) % gsz); u.pn = (wgid % nig) / gsz; return true;
    }
    __device__ __forceinline__ void a_ready(const Unit&) const {}
    __device__ __forceinline__ void done(const Unit&) const {}
};


template <class Epi, class Sched, bool ALIGN_EPI = false, bool SP2 = false>
__device__ __forceinline__ void gemm_phase(PG8_LAS unsigned char* lds, const Gemm g, const Sched& S, const Epi& E) {
    const int tid = threadIdx.x, wid = __builtin_amdgcn_readfirstlane(tid >> 6), lane = tid & 63, wr = wid >> 2, wc = wid & 3, fr = lane & 15, fq = lane >> 4;
    const int K = g.K, nt = K / BK;
    unsigned voffA[2], voffB[2];
#pragma unroll
    for (int i = 0; i < 2; ++i) { int R, C; stage_rc(tid * 16 + i * 8192, R, C); const int Rb = Epi::PERM ? ((R & ~31) + perm32(R & 31)) : R;
        voffA[i] = (unsigned)(R * g.lda + C) * 2u; voffB[i] = (unsigned)(Rb * g.ldb + C) * 2u; }
    const size_t kstep = (size_t)(BK * 2);
    const size_t hstepA = (size_t)HALF * g.lda * 2, hstepB = (size_t)HALF * g.ldb * 2;
    const size_t tstepA = 2 * hstepA, tstepB = 2 * hstepB;
    const unsigned ldsw = (unsigned)wid * 1024u;
    const int aoff = lds_byte(wr * 64 + fr, fq * 8), boff = lds_byte(wc * 32 + fr, fq * 8);
#define PG8_SA(b, h) (((b) * 2 + (h)) * HTB)
#define PG8_SB(b, h) ((4 + (b) * 2 + (h)) * HTB)
#define PG8_STAGE(bufoff, gbase, voff) do { _Pragma("unroll") for (int _i = 0; _i < 2; ++_i) \
        __builtin_amdgcn_global_load_lds((const unsigned*)((const char*)(gbase) + (voff)[_i]), (PG8_LAS unsigned*)(lds + (bufoff) + ldsw + _i * 8192), 16, 0, 0); } while (0)
#define PG8_LDA(dst, b, h) do { _Pragma("unroll") for (int m = 0; m < 4; ++m) _Pragma("unroll") for (int k = 0; k < 2; ++k) dst[m][k] = *(const PG8_LAS bf16x8*)(lds + PG8_SA(b, h) + aoff + m * 2048 + k * 1024); } while (0)
#define PG8_LDB(dst, b, h) do { _Pragma("unroll") for (int n = 0; n < 2; ++n) _Pragma("unroll") for (int k = 0; k < 2; ++k) dst[n][k] = *(const PG8_LAS bf16x8*)(lds + PG8_SB(b, h) + boff + n * 2048 + k * 1024); } while (0)
#define PG8_MMA(ai, bj, At, Bt) do { __builtin_amdgcn_s_setprio(1); _Pragma("unroll") for (int m = 0; m < 4; ++m) _Pragma("unroll") for (int n = 0; n < 2; ++n) _Pragma("unroll") for (int k = 0; k < 2; ++k) \
        acc[ai][bj][m][n] = __builtin_amdgcn_mfma_f32_16x16x32_bf16(Bt[n][k], At[m][k], acc[ai][bj][m][n], 0, 0, 0); __builtin_amdgcn_s_setprio(0); } while (0)
#define PG8_WAIT_V(n) asm volatile("s_waitcnt vmcnt(" #n ")" ::: "memory")
#define PG8_WAIT_L(n) asm volatile("s_waitcnt lgkmcnt(" #n ")" ::: "memory")
#define PG8_BAR __builtin_amdgcn_s_barrier()
#define PG8_SCHED __builtin_amdgcn_sched_barrier(0)
    Unit cur, nxt; int ui = 0;
    if (!S.next(0, cur)) return;
    f32x4 acc[2][2][4][2];
#pragma unroll
    for (int a = 0; a < 2; ++a)
#pragma unroll
        for (int b = 0; b < 2; ++b)
#pragma unroll
            for (int m = 0; m < 4; ++m)
#pragma unroll
                for (int n = 0; n < 2; ++n) acc[a][b][m][n] = (f32x4){0.f, 0.f, 0.f, 0.f};
    bf16x8 At[4][2], B0[2][2], B1[2][2];
    const char* cA = (const char*)g.A + (size_t)cur.pm * tstepA; const char* cB = (const char*)g.Bt + (size_t)cur.pn * tstepB;
    S.a_ready(cur);
    if constexpr (SP2) {
        PG8_STAGE(PG8_SB(0, 0), cB, voffB); PG8_STAGE(PG8_SB(0, 1), cB + hstepB, voffB); PG8_STAGE(PG8_SA(0, 0), cA, voffA); PG8_STAGE(PG8_SA(0, 1), cA + hstepA, voffA);
        if (wr == 1) PG8_BAR;
        PG8_WAIT_V(2); PG8_BAR;
        PG8_STAGE(PG8_SB(1, 0), cB + kstep, voffB); PG8_STAGE(PG8_SA(1, 0), cA + kstep, voffA); PG8_STAGE(PG8_SB(1, 1), cB + hstepB + kstep, voffB);
        PG8_WAIT_V(6); PG8_BAR;
    } else {
        PG8_STAGE(PG8_SB(0, 0), cB, voffB); PG8_STAGE(PG8_SA(0, 0), cA, voffA); PG8_STAGE(PG8_SB(0, 1), cB + hstepB, voffB); PG8_STAGE(PG8_SA(0, 1), cA + hstepA, voffA);
        if (wr == 1) PG8_BAR;
        PG8_WAIT_V(4); PG8_BAR;
        PG8_STAGE(PG8_SB(1, 0), cB + kstep, voffB); PG8_STAGE(PG8_SA(1, 0), cA + kstep, voffA); PG8_STAGE(PG8_SB(1, 1), cB + hstepB + kstep, voffB);
        PG8_WAIT_V(6); PG8_BAR;
    }
    for (;;) {
        const bool has_next = S.next(ui + 1, nxt);
        const char* nA = has_next ? (const char*)g.A + (size_t)nxt.pm * tstepA : cA; const char* nB = has_next ? (const char*)g.Bt + (size_t)nxt.pn * tstepB : cB;
#pragma unroll 1
        for (int t = 0; t < nt; t += 2) {
            const bool last = (t == nt - 2);
            const char* a1 = cA + (size_t)(t + 1) * kstep;
            const char* a2 = last ? nA : cA + (size_t)(t + 2) * kstep; const char* b2 = last ? nB : cB + (size_t)(t + 2) * kstep;
            const char* a3 = a2 + kstep; const char* b3 = b2 + kstep;
            if (last && has_next) S.a_ready(nxt);
            if constexpr (SP2) {
            PG8_LDB(B0, 0, 0); PG8_LDB(B1, 0, 1); PG8_SCHED; PG8_LDA(At, 0, 0); PG8_STAGE(PG8_SA(1, 1), a1 + hstepA, voffA);
            PG8_WAIT_V(8); PG8_WAIT_L(0); PG8_BAR; PG8_MMA(0, 0, At, B0); PG8_MMA(0, 1, At, B1); PG8_BAR; PG8_SCHED;
            PG8_LDA(At, 0, 1); PG8_STAGE(PG8_SB(0, 0), b2, voffB); PG8_STAGE(PG8_SB(0, 1), b2 + hstepB, voffB); PG8_STAGE(PG8_SA(0, 0), a2, voffA);
            PG8_WAIT_V(8); PG8_WAIT_L(0); PG8_BAR; PG8_MMA(1, 0, At, B0); PG8_MMA(1, 1, At, B1); PG8_BAR; PG8_SCHED;
            PG8_LDB(B0, 1, 0); PG8_LDB(B1, 1, 1); PG8_SCHED; PG8_LDA(At, 1, 0); PG8_STAGE(PG8_SA(0, 1), a2 + hstepA, voffA);
            PG8_WAIT_V(8); PG8_WAIT_L(0); PG8_BAR; PG8_MMA(0, 0, At, B0); PG8_MMA(0, 1, At, B1); PG8_BAR; PG8_SCHED;
            PG8_LDA(At, 1, 1); PG8_STAGE(PG8_SB(1, 0), b3, voffB); PG8_STAGE(PG8_SB(1, 1), b3 + hstepB, voffB); PG8_STAGE(PG8_SA(1, 0), a3, voffA);
            PG8_WAIT_V(8); PG8_WAIT_L(0); PG8_BAR; PG8_MMA(1, 0, At, B0); PG8_MMA(1, 1, At, B1); PG8_BAR; PG8_SCHED;
            } else {
            PG8_LDB(B0, 0, 0); PG8_SCHED; PG8_LDA(At, 0, 0); PG8_STAGE(PG8_SA(1, 1), a1 + hstepA, voffA);
            PG8_WAIT_L(8); PG8_BAR; PG8_WAIT_L(0); PG8_MMA(0, 0, At, B0); PG8_BAR; PG8_SCHED;
            PG8_LDB(B1, 0, 1); PG8_STAGE(PG8_SB(0, 0), b2, voffB);
            PG8_BAR; PG8_WAIT_L(0); PG8_MMA(0, 1, At, B1); PG8_BAR;
            PG8_LDA(At, 0, 1); PG8_STAGE(PG8_SA(0, 0), a2, voffA);
            PG8_BAR; PG8_WAIT_L(0); PG8_MMA(1, 0, At, B0); PG8_BAR; PG8_SCHED;
            PG8_STAGE(PG8_SB(0, 1), b2 + hstepB, voffB);
            PG8_WAIT_V(6); PG8_BAR; PG8_MMA(1, 1, At, B1); PG8_BAR;
            PG8_LDB(B0, 1, 0); PG8_SCHED; PG8_LDA(At, 1, 0); PG8_STAGE(PG8_SA(0, 1), a2 + hstepA, voffA);
            PG8_WAIT_L(8); PG8_BAR; PG8_WAIT_L(0); PG8_MMA(0, 0, At, B0); PG8_BAR; PG8_SCHED;
            PG8_LDB(B1, 1, 1); PG8_STAGE(PG8_SB(1, 0), b3, voffB);
            PG8_BAR; PG8_WAIT_L(0); PG8_MMA(0, 1, At, B1); PG8_BAR;
            PG8_LDA(At, 1, 1); PG8_STAGE(PG8_SA(1, 0), a3, voffA);
            PG8_BAR; PG8_WAIT_L(0); PG8_MMA(1, 0, At, B0); PG8_BAR; PG8_SCHED;
            PG8_STAGE(PG8_SB(1, 1), b3 + hstepB, voffB);
            PG8_WAIT_V(6); PG8_BAR; PG8_MMA(1, 1, At, B1); PG8_BAR;
            }
        }
        if constexpr (ALIGN_EPI) { if (wr == 0) PG8_BAR; }
        if constexpr (!Epi::AFTER_DRAIN) { E(acc, cur, wr, wc, fr, fq); S.done(cur); }
        if (!has_next) break;
#pragma unroll
        for (int a = 0; a < 2; ++a)
#pragma unroll
            for (int b = 0; b < 2; ++b)
#pragma unroll
                for (int m = 0; m < 4; ++m)
#pragma unroll
                    for (int n = 0; n < 2; ++n) acc[a][b][m][n] = (f32x4){0.f, 0.f, 0.f, 0.f};
        cur = nxt; cA = nA; cB = nB; ++ui;
        if constexpr (ALIGN_EPI) { if (wr == 1) PG8_BAR; }
    }
    PG8_WAIT_V(0);
    if constexpr (!ALIGN_EPI) { if (wr == 0) PG8_BAR; }
    PG8_BAR;
    if constexpr (Epi::AFTER_DRAIN) { E.fused(acc, cur, wr, wc, fr, fq, lds, wid, lane); S.done(cur); }
#undef PG8_SA
#undef PG8_SB
#undef PG8_STAGE
#undef PG8_LDA
#undef PG8_LDB
#undef PG8_MMA
#undef PG8_WAIT_V
#undef PG8_WAIT_L
#undef PG8_BAR
#undef PG8_SCHED
}
}

using pg8::bf16_t; using pg8::bf16x8; using pg8::f32x4; using pg8::u32x4; using pg8::Unit;
typedef unsigned u32x2 __attribute__((ext_vector_type(2)));
typedef float f32x2_t __attribute__((ext_vector_type(2)));
typedef __bf16 bf16x2_t __attribute__((ext_vector_type(2)));
#define LAS __attribute__((address_space(3)))

__device__ __forceinline__ unsigned f2bf(float f) { unsigned u = __builtin_bit_cast(unsigned, f); return (u + 0x7fffu + ((u >> 16) & 1u)) >> 16; }
__device__ __forceinline__ float bf2f(unsigned b) { return __builtin_bit_cast(float, b << 16); }
__device__ __forceinline__ float bflo(unsigned w) { return __builtin_bit_cast(float, w << 16); }
__device__ __forceinline__ float bfhi(unsigned w) { return __builtin_bit_cast(float, w & 0xffff0000u); }
__device__ __forceinline__ unsigned pk2(float lo, float hi) { f32x2_t v = {lo, hi}; bf16x2_t b = __builtin_convertvector(v, bf16x2_t); return __builtin_bit_cast(unsigned, b); }
__device__ __forceinline__ float wave_sum(float v) {
#pragma unroll
    for (int o = 1; o < 64; o <<= 1) v += __shfl_xor(v, o);
    return v;
}
__device__ __forceinline__ float sigmoidf_(float z) { return __builtin_amdgcn_rcpf(1.f + __builtin_amdgcn_exp2f(-z * LOG2E)); }
__device__ __forceinline__ int rope_perm(int p) { return (p >> 4) * 16 + (p & 1) * 8 + ((p & 15) >> 1); }

typedef const f32x4 (&AccRef)[2][2][4][2];
__device__ __forceinline__ void store_bf16_tile(AccRef acc, bf16_t* base, int ldc, int row0, int col0, float sc = 1.f) {
#pragma unroll
    for (int ai = 0; ai < 2; ++ai)
#pragma unroll
        for (int m = 0; m < 4; ++m) { bf16_t* rowp = base + (size_t)(row0 + ai * 128 + m * 16) * ldc + col0;
#pragma unroll
            for (int bj = 0; bj < 2; ++bj) { const f32x4 v0 = acc[ai][bj][m][0] * sc, v1 = acc[ai][bj][m][1] * sc;
                *(u32x4*)(rowp + bj * 128) = (u32x4){pk2(v0[0], v0[1]), pk2(v0[2], v0[3]), pk2(v1[0], v1[1]), pk2(v1[2], v1[3])}; } }
}
struct EpiG1 {
    static constexpr bool PERM = true, AFTER_DRAIN = false;
    bf16_t *qkv, *lat, *g;
    __device__ __forceinline__ void operator()(AccRef acc, const Unit& u, int wr, int wc, int fr, int fq) const {
        bf16_t* base; int ldc, colt;
        if (u.pn < 6) { base = qkv; ldc = 1536; colt = u.pn * 256; } else if (u.pn < 8) { base = lat; ldc = 512; colt = (u.pn - 6) * 256; } else { base = g; ldc = 2048; colt = (u.pn - 8) * 256; }
        store_bf16_tile(acc, base, ldc, u.pm * 256 + wr * 64 + fr, colt + wc * 32 + 8 * fq, u.pn < 2 ? 0.125f * LOG2E : 1.f);
    }
};
struct EpiPlain {
    static constexpr bool PERM = true, AFTER_DRAIN = false;
    bf16_t* base; int ldc;
    __device__ __forceinline__ void operator()(AccRef acc, const Unit& u, int wr, int wc, int fr, int fq) const { store_bf16_tile(acc, base, ldc, u.pm * 256 + wr * 64 + fr, u.pn * 256 + wc * 32 + 8 * fq); }
};
struct EpiQ {
    static constexpr bool PERM = true, AFTER_DRAIN = false;
    bf16_t* qm; const float* tab;
    __device__ __forceinline__ void operator()(AccRef acc, const Unit& u, int wr, int wc, int fr, int fq) const {
        const float sc = 0.10206207261596577f * LOG2E;
        const int row0 = u.pm * 256 + wr * 64 + fr, colb = u.pn * 256 + wc * 32 + 8 * fq;
#pragma unroll
        for (int bj = 0; bj < 2; ++bj) {
            const int col = colb + bj * 128, d0 = col % 96, pidx0 = d0 - 64, part = pidx0 >> 4, i0 = (pidx0 & 15) >> 1;
#pragma unroll
            for (int ai = 0; ai < 2; ++ai)
#pragma unroll
                for (int m = 0; m < 4; ++m) {
                    const int row = row0 + ai * 128 + m * 16;
                    f32x4 v0 = acc[ai][bj][m][0], v1 = acc[ai][bj][m][1];
                    if (d0 >= 64 && !PROBE_NOROPE) {
                        const int t = row & (SEQ - 1), pos = part ? (t & 63) : (t >> 6);
                        const f32x4 c0 = *(const f32x4*)(tab + (pos * 8 + i0) * 2), c1 = *(const f32x4*)(tab + (pos * 8 + i0) * 2 + 4);
                        v0 = (f32x4){v0[0] * c0[0] - v0[1] * c0[1], v0[1] * c0[0] + v0[0] * c0[1], v0[2] * c0[2] - v0[3] * c0[3], v0[3] * c0[2] + v0[2] * c0[3]};
                        v1 = (f32x4){v1[0] * c1[0] - v1[1] * c1[1], v1[1] * c1[0] + v1[0] * c1[1], v1[2] * c1[2] - v1[3] * c1[3], v1[3] * c1[2] + v1[2] * c1[3]};
                    }
                    v0 = v0 * sc; v1 = v1 * sc;
                    *(u32x4*)(qm + (size_t)row * 768 + col) = (u32x4){pk2(v0[0], v0[1]), pk2(v0[2], v0[3]), pk2(v1[0], v1[1]), pk2(v1[2], v1[3])};
                    asm volatile("" ::: "memory");
                }
        }
    }
};
template <bool SECOND> struct EpiGate {
    static constexpr bool PERM = true, AFTER_DRAIN = false;
    bf16_t* mg; const bf16_t* g; const float* bg;
    __device__ __forceinline__ void operator()(AccRef acc, const Unit& u, int wr, int wc, int fr, int fq) const {
        const int row0 = u.pm * 256 + wr * 64 + fr, colb = u.pn * 256 + wc * 32 + 8 * fq, goff = SECOND ? 1024 : 0;
#pragma unroll
        for (int bj = 0; bj < 2; ++bj) {
            const int col = colb + bj * 128;
            const f32x4 b0 = *(const f32x4*)(bg + goff + col), b1 = *(const f32x4*)(bg + goff + col + 4);
#pragma unroll
            for (int ai = 0; ai < 2; ++ai)
#pragma unroll
                for (int m = 0; m < 4; ++m) {
                    const int row = row0 + ai * 128 + m * 16;
                    const u32x4 gv = *(const u32x4*)(g + (size_t)row * 2048 + goff + col);
                    f32x4 a0 = acc[ai][bj][m][0], a1 = acc[ai][bj][m][1];
                    if ((PROBE_ZERO == 1 && !SECOND) || (PROBE_ZERO == 2 && SECOND)) { a0 = a0 * 0.f; a1 = a1 * 0.f; }
                    { const float psc = SECOND ? PROBE_SC_MLA : PROBE_SC_NA; a0 = a0 * psc; a1 = a1 * psc; }
                    float o[8];
                    o[0] = sigmoidf_(bflo(gv[0]) + b0[0]) * a0[0]; o[1] = sigmoidf_(bfhi(gv[0]) + b0[1]) * a0[1];
                    o[2] = sigmoidf_(bflo(gv[1]) + b0[2]) * a0[2]; o[3] = sigmoidf_(bfhi(gv[1]) + b0[3]) * a0[3];
                    o[4] = sigmoidf_(bflo(gv[2]) + b1[0]) * a1[0]; o[5] = sigmoidf_(bfhi(gv[2]) + b1[1]) * a1[1];
                    o[6] = sigmoidf_(bflo(gv[3]) + b1[2]) * a1[2]; o[7] = sigmoidf_(bfhi(gv[3]) + b1[3]) * a1[3];
                    u32x4* dst = (u32x4*)(mg + (size_t)row * DM + col);
                    if (SECOND) { const u32x4 old = *dst;
#pragma unroll
                        for (int e = 0; e < 4; ++e) { o[2 * e] += bflo(old[e]); o[2 * e + 1] += bfhi(old[e]); } }
                    *dst = (u32x4){pk2(o[0], o[1]), pk2(o[2], o[3]), pk2(o[4], o[5]), pk2(o[6], o[7])};
                }
        }
    }
};
struct EpiRes {
    static constexpr bool PERM = false, AFTER_DRAIN = false;
    const float* base; float* y;
    __device__ __forceinline__ void operator()(AccRef acc, const Unit& u, int wr, int wc, int fr, int fq) const {
#pragma unroll
        for (int ai = 0; ai < 2; ++ai)
#pragma unroll
            for (int m = 0; m < 4; ++m) { const size_t roff = (size_t)(u.pm * 256 + ai * 128 + wr * 64 + m * 16 + fr) * DM + u.pn * 256 + wc * 32 + 4 * fq;
#pragma unroll
                for (int bj = 0; bj < 2; ++bj)
#pragma unroll
                    for (int n = 0; n < 2; ++n) { const size_t off = roff + bj * 128 + n * 16; const f32x4 b = *(const f32x4*)(base + off); *(f32x4*)(y + off) = b * DN_ALPHA + acc[ai][bj][m][n]; } }
    }
};
struct EpiSwiglu {
    static constexpr bool PERM = true, AFTER_DRAIN = false;
    bf16_t* hid;
    __device__ __forceinline__ void operator()(AccRef acc, const Unit& u, int wr, int wc, int fr, int fq) const {
        const int row0 = u.pm * 256 + wr * 64 + fr, col = u.pn * 128 + wc * 32 + 8 * fq;
#pragma unroll
        for (int ai = 0; ai < 2; ++ai)
#pragma unroll
            for (int m = 0; m < 4; ++m) {
                const f32x4 g0 = acc[ai][0][m][0], g1 = acc[ai][0][m][1], u0 = acc[ai][1][m][0], u1 = acc[ai][1][m][1];
                float o[8];
#pragma unroll
                for (int e = 0; e < 4; ++e) { o[e] = g0[e] * sigmoidf_(g0[e]) * u0[e]; o[4 + e] = g1[e] * sigmoidf_(g1[e]) * u1[e]; }
                *(u32x4*)(hid + (size_t)(row0 + ai * 128 + m * 16) * FFH + col) = (u32x4){pk2(o[0], o[1]), pk2(o[2], o[3]), pk2(o[4], o[5]), pk2(o[6], o[7])};
            }
    }
};

__device__ __forceinline__ int colmap(int mode, int n) {
    if (mode == 1) {
        if (n < 1920) return n;
        if (n < 1952) return 1920 + rope_perm(n - 1920);
        if (n < 2048) return -1;
        return n - 96;
    }
    if (mode == 2) {
        const int h = n / 96, d = n % 96;
        return d < 64 ? n : h * 96 + 64 + rope_perm(d - 64);
    }
    if (mode == 3) {
        const int t = n >> 8, w = n & 255;
        return w < 128 ? 128 * t + w : FFH + 128 * t + (w - 128);
    }
    return n;
}
__device__ void transpose_w(const float* __restrict__ W, int K, int Nsrc, bf16_t* __restrict__ Wt, int ldk, int Ndst, int mode, float* tile, int bid, int nb) {
    const int tid = threadIdx.x, nw = blockDim.x >> 6, nkt = K / 64, nnt = Ndst / 64;
    for (int t = bid; t < nkt * nnt; t += nb) {
        const int kt = t / nnt, nt = t % nnt;
        const int n = nt * 64 + (tid & 63), src = colmap(mode, n);
        for (int kl = tid >> 6; kl < 64; kl += nw) tile[kl * 65 + (tid & 63)] = src >= 0 ? W[(size_t)(kt * 64 + kl) * Nsrc + src] : 0.f;
        __syncthreads();
        for (int nl = tid >> 6; nl < 64; nl += nw) Wt[(size_t)(nt * 64 + nl) * ldk + kt * 64 + (tid & 63)] = (bf16_t)f2bf(tile[(tid & 63) * 65 + nl]);
        __syncthreads();
    }
}
__device__ void stage0(const Params& p, float* smem, int bid, int nb) {
    unsigned char* ws = p.ws;
    transpose_w(p.w_in, DM, 4000, (bf16_t*)(ws + WS_WIN), DM, HP, 1, smem, bid, nb);
    transpose_w(p.w_uq, QLORA, MH * QK, (bf16_t*)(ws + WS_WUQ), QLORA, MH * QK, 2, smem, bid, nb);
    transpose_w(p.w_ukv, KVLORA, 1024, (bf16_t*)(ws + WS_WUKV), 256, 1024, 0, smem, bid, nb);
    transpose_w(p.w_bna, 512, DM, (bf16_t*)(ws + WS_WBNA), 512, DM, 0, smem, bid, nb);
    transpose_w(p.w_bmla, 512, DM, (bf16_t*)(ws + WS_WBMLA), 512, DM, 0, smem, bid, nb);
    transpose_w(p.w_out, DM, DM, (bf16_t*)(ws + WS_WOUT), DM, DM, 0, smem, bid, nb);
    transpose_w(p.w_fi, DM, 2 * FFH, (bf16_t*)(ws + WS_WFI), DM, 2 * FFH, 3, smem, bid, nb);
    transpose_w(p.w_fo, FFH, DM, (bf16_t*)(ws + WS_WFO), FFH, DM, 0, smem, bid, nb);
    {
        bf16_t* wt = (bf16_t*)(ws + WS_WUKV);
        for (int i = bid * blockDim.x + threadIdx.x; i < 1024 * 16; i += nb * blockDim.x) { const int n = i >> 4, c = i & 15; *(u32x4*)(wt + (size_t)n * 256 + 128 + 8 * c) = (u32x4){0u, 0u, 0u, 0u}; }
    }
    const f32x4* xs = (const f32x4*)p.x; u32x4* xd = (u32x4*)(ws + WS_XB);
    for (size_t i = (size_t)bid * blockDim.x + threadIdx.x; i < (size_t)M * DM / 8; i += (size_t)nb * blockDim.x) {
        const f32x4 a = xs[2 * i], b = xs[2 * i + 1];
        xd[i] = (u32x4){pk2(a[0], a[1]), pk2(a[2], a[3]), pk2(b[0], b[1]), pk2(b[2], b[3])};
    }
    if (bid == 0) {
        float2* tab = (float2*)(ws + WS_ROPE);
        for (int e = threadIdx.x; e < 64 * 8; e += blockDim.x) {
            const int pos = e >> 3, i = e & 7;
            const float inv = __builtin_amdgcn_exp2f(-(float)i * 0.125f * 13.287712379549449f);
            const float rev = (float)pos * inv * 0.15915494309189535f;
            tab[e] = make_float2(__builtin_amdgcn_cosf(rev), __builtin_amdgcn_sinf(rev));
        }
    }
}

__device__ void stage_lat(const Params& p, int bid, int nb) {
    const int lane = threadIdx.x & 63, gw = bid * (blockDim.x >> 6) + (threadIdx.x >> 6), ngw = nb * (blockDim.x >> 6);
    bf16_t* lat = (bf16_t*)(p.ws + WS_LAT); bf16_t* kpe = (bf16_t*)(p.ws + WS_KPE);
    const float2* tab = (const float2*)(p.ws + WS_ROPE);
    for (int row = gw; row < M; row += ngw) {
        bf16_t* lr = lat + (size_t)row * 512;
        {
            const u32x2 v = *(const u32x2*)(lr + 4 * lane);
            const float a0 = bflo(v.x), a1 = bfhi(v.x), a2 = bflo(v.y), a3 = bfhi(v.y);
            const float rs = rsqrtf(wave_sum(a0 * a0 + a1 * a1 + a2 * a2 + a3 * a3) * (1.f / 256.f) + RMS_EPS);
            const f32x4 g = *(const f32x4*)(p.qn + 4 * lane);
            *(u32x2*)(lr + 4 * lane) = (u32x2){pk2(a0 * rs * g[0], a1 * rs * g[1]), pk2(a2 * rs * g[2], a3 * rs * g[3])};
        }
        {
            const unsigned v = *(const unsigned*)(lr + 256 + 2 * lane);
            const float a0 = bflo(v), a1 = bfhi(v);
            const float rs = rsqrtf(wave_sum(a0 * a0 + a1 * a1) * (1.f / 128.f) + RMS_EPS);
            *(unsigned*)(lr + 256 + 2 * lane) = pk2(a0 * rs * p.kvn[2 * lane], a1 * rs * p.kvn[2 * lane + 1]);
        }
        {
            const int pidx = lane & 31, part = pidx >> 4, i = (pidx & 15) >> 1, odd = pidx & 1;
            const float v = bf2f(lr[384 + pidx]);
            const int t = row & (SEQ - 1), pos = part ? (t & 63) : (t >> 6);
            const float2 cs = tab[pos * 8 + i];
            const float partner = __shfl_xor(v, 1);
            float o = v * cs.x + (odd ? partner : -partner) * cs.y;
            if (PROBE_NOROPE) o = v;
            if (lane < 32) kpe[(size_t)row * 32 + pidx] = (bf16_t)f2bf(o);
        }
    }
}

namespace mla {
typedef float f32x16 __attribute__((ext_vector_type(16)));
typedef short s16x4 __attribute__((ext_vector_type(4)));
typedef short v4i16_t __attribute__((ext_vector_type(4)));
typedef LAS const char* lds_cptr;
constexpr int KSLOT = 12288, VSLOT = 8192, NSLOT = 3, NT = SEQ / 64;
constexpr int L_K = 0, L_V = NSLOT * KSLOT, L_WS = L_V + NSLOT * VSLOT, L_OST = L_WS + 8 * 64 * 4, L_END = L_OST + 8 * 4096;
constexpr float THR = 5.0f;
__device__ __forceinline__ int crow(int r, int hi) { return (r & 3) + 8 * (r >> 2) + 4 * hi; }
__device__ __forceinline__ void glds16(const void* gsrc, unsigned lds_dst) { unsigned keep;
    asm volatile("s_mov_b32 %0, m0\n\ts_mov_b32 m0, %2\n\ts_nop 0\n\tglobal_load_lds_dwordx4 %1, off\n\ts_mov_b32 m0, %0" : "=&s"(keep) : "v"(gsrc), "s"(lds_dst) : "memory"); }
__device__ __forceinline__ s16x4 vtr(lds_cptr p) { return __builtin_bit_cast(s16x4, __builtin_amdgcn_ds_read_tr16_b64_v4i16((LAS v4i16_t*)p)); }
#define MLA_WAIT_BAR(N) asm volatile("s_waitcnt vmcnt(" #N ") lgkmcnt(0)\n\ts_barrier" ::: "memory")

__device__ __forceinline__ void unit(int b, int h, int qb, const bf16_t* __restrict__ QM, const bf16_t* __restrict__ KVM, const bf16_t* __restrict__ KPE, bf16_t* __restrict__ AO, unsigned char* shm) {
    const int tid = threadIdx.x, lane = tid & 63, r32 = lane & 31, hi = lane >> 5; const int wid = __builtin_amdgcn_readfirstlane(tid >> 6);
    const size_t rowbase = (size_t)b * SEQ; const int q0 = qb * 256;
    const unsigned lds0 = (unsigned)(uintptr_t)shm;
    const lds_cptr shm3 = (lds_cptr)shm;
    LAS float* wsf = (LAS float*)(shm3 + L_WS) + wid * 64;
    const bf16_t* ksrc = KVM + (rowbase + lane) * 1024 + h * 128 + wid * 8;
    const bf16_t* psrc = KPE + (rowbase + lane) * 32 + (wid & 3) * 8;
    const bf16_t* vsrc = KVM + (rowbase + 16 * (wid & 3) + (lane >> 2)) * 1024 + h * 128 + 64 + (wid >> 2) * 32 + (lane & 3) * 8;
    const unsigned kdst = lds0 + L_K + wid * 1024, pdst = lds0 + L_K + (8 + (wid & 3)) * 1024, vdst = lds0 + L_V + wid * 1024;
#define MLA_DMA(t, s) do { glds16(ksrc + (size_t)(t) * 64 * 1024, (unsigned)__builtin_amdgcn_readfirstlane(kdst + (s) * KSLOT)); \
        if (wid < 4) glds16(psrc + (size_t)(t) * 64 * 32, (unsigned)__builtin_amdgcn_readfirstlane(pdst + (s) * KSLOT)); \
        glds16(vsrc + (size_t)(t) * 64 * 1024, (unsigned)__builtin_amdgcn_readfirstlane(vdst + (s) * VSLOT)); } while (0)
    MLA_DMA(0, 0); MLA_DMA(1, 1);
    bf16x8 qr[6];
    { const bf16_t* qp = QM + (rowbase + q0 + wid * 32 + r32) * 768 + h * 96 + hi * 8;
#pragma unroll
      for (int d0 = 0; d0 < 6; ++d0) qr[d0] = *(const bf16x8*)(qp + d0 * 16); }
    float m = -INFINITY, l = 0.f; f32x16 o0 = {}, o1 = {};
    const lds_cptr kp0 = shm3 + L_K + hi * 1024 + r32 * 16;
    const lds_cptr vp0 = shm3 + L_V + ((lane >> 4) & 1) * 32 + (lane & 3) * 8 + (4 * hi + ((lane & 15) >> 2)) * 64;
    int slot = 0;
    for (int t = 0; t < NT; ++t) {
        if (t + 1 < NT) { if (wid < 4) MLA_WAIT_BAR(3); else MLA_WAIT_BAR(2); } else MLA_WAIT_BAR(0);
        if (t + 2 < NT) { const int s2 = slot == 0 ? 2 : slot - 1; MLA_DMA(t + 2, s2); }
        const lds_cptr kp = kp0 + slot * KSLOT; const lds_cptr vp = vp0 + slot * VSLOT;
        f32x16 p0 = {}, p1 = {};
#pragma unroll
        for (int d0 = 0; d0 < 6; ++d0) {
            const bf16x8 k0 = *(const LAS bf16x8*)(kp + d0 * 2048), k1 = *(const LAS bf16x8*)(kp + d0 * 2048 + 512);
            p0 = __builtin_amdgcn_mfma_f32_32x32x16_bf16(k0, qr[d0], p0, 0, 0, 0);
            p1 = __builtin_amdgcn_mfma_f32_32x32x16_bf16(k1, qr[d0], p1, 0, 0, 0);
        }
        float rm = fmaxf(p0[0], p1[0]);
#pragma unroll
        for (int r = 1; r < 16; ++r) rm = fmaxf(rm, fmaxf(p0[r], p1[r]));
        { auto rr = __builtin_amdgcn_permlane32_swap(__float_as_uint(rm), __float_as_uint(rm), false, false); rm = fmaxf(__uint_as_float(rr[0]), __uint_as_float(rr[1])); }
        if (__any(rm > m + THR)) {
            const float mn = fmaxf(m, rm), f = __builtin_amdgcn_exp2f(m - mn);
            m = mn; l *= f;
            if (hi == 0) wsf[r32] = f;
            asm volatile("s_waitcnt lgkmcnt(0)" ::: "memory");
#pragma unroll
            for (int r = 0; r < 16; ++r) { const float fr_ = wsf[crow(r, hi)]; o0[r] *= fr_; o1[r] *= fr_; }
        }
        float sacc = 0.f;
#pragma unroll
        for (int r = 0; r < 16; ++r) { p0[r] = __builtin_amdgcn_exp2f(p0[r] - m); p1[r] = __builtin_amdgcn_exp2f(p1[r] - m); sacc += p0[r] + p1[r]; }
        l += sacc;
        const u32x4 pw0 = {pk2(p0[0], p0[1]), pk2(p0[2], p0[3]), pk2(p0[4], p0[5]), pk2(p0[6], p0[7])};
        const u32x4 pw1 = {pk2(p0[8], p0[9]), pk2(p0[10], p0[11]), pk2(p0[12], p0[13]), pk2(p0[14], p0[15])};
        const u32x4 pw2 = {pk2(p1[0], p1[1]), pk2(p1[2], p1[3]), pk2(p1[4], p1[5]), pk2(p1[6], p1[7])};
        const u32x4 pw3 = {pk2(p1[8], p1[9]), pk2(p1[10], p1[11]), pk2(p1[12], p1[13]), pk2(p1[14], p1[15])};
#define MLA_PV(O, D0, KS, PW) do { const s16x4 lo_ = vtr(vp + ((D0) * 4096 + (KS) * 1024)), hi_ = vtr(vp + ((D0) * 4096 + (KS) * 1024 + 512)); \
        const bf16x8 vf_ = {lo_[0], lo_[1], lo_[2], lo_[3], hi_[0], hi_[1], hi_[2], hi_[3]}; \
        O = __builtin_amdgcn_mfma_f32_32x32x16_bf16(__builtin_bit_cast(bf16x8, PW), vf_, O, 0, 0, 0); } while (0)
        MLA_PV(o0, 0, 0, pw0); MLA_PV(o1, 1, 0, pw0); MLA_PV(o0, 0, 1, pw1); MLA_PV(o1, 1, 1, pw1);
        MLA_PV(o0, 0, 2, pw2); MLA_PV(o1, 1, 2, pw2); MLA_PV(o0, 0, 3, pw3); MLA_PV(o1, 1, 3, pw3);
#undef MLA_PV
        slot = slot == 2 ? 0 : slot + 1;
    }
    { auto rr = __builtin_amdgcn_permlane32_swap(__float_as_uint(l), __float_as_uint(l), false, false); l = __uint_as_float(rr[0]) + __uint_as_float(rr[1]); }
    if (hi == 0) wsf[32 + r32] = l;
    asm volatile("s_waitcnt lgkmcnt(0)" ::: "memory");
    LAS bf16_t* stg = (LAS bf16_t*)(shm3 + L_OST) + wid * 2048;
#pragma unroll
    for (int r = 0; r < 16; ++r) { const int orow = crow(r, hi); const float il = __builtin_amdgcn_rcpf(wsf[32 + orow]);
        stg[orow * 64 + r32] = (bf16_t)f2bf(o0[r] * il); stg[orow * 64 + 32 + r32] = (bf16_t)f2bf(o1[r] * il); }
    asm volatile("s_waitcnt lgkmcnt(0)" ::: "memory");
    bf16_t* Ow = AO + (rowbase + q0 + wid * 32) * 1024 + 512 + h * 64;
#pragma unroll
    for (int i = 0; i < 4; ++i) { const int row = i * 8 + (lane >> 3), ch = lane & 7; const u32x4 v = *(const LAS u32x4*)(stg + row * 64 + ch * 8); *(u32x4*)(Ow + (size_t)row * 1024 + ch * 8) = v; }
    asm volatile("s_waitcnt lgkmcnt(0)\n\ts_barrier" ::: "memory");
#undef MLA_DMA
}
__device__ __forceinline__ void phase(const Params& p, unsigned char* shm, int bid, int nb) {
    const int vcu = (nb % 8 == 0) ? (bid % 8) * (nb / 8) + bid / 8 : bid;
    const bf16_t* qm = (const bf16_t*)(p.ws + WS_QM); const bf16_t* kvm = (const bf16_t*)(p.ws + WS_KVM); const bf16_t* kpe = (const bf16_t*)(p.ws + WS_KPE); bf16_t* ao = (bf16_t*)(p.ws + WS_AO);
    const int nunits = 4 * 8 * 16, per = (nunits + nb - 1) / nb;
    for (int i = 0; i < per; ++i) { const int u = vcu * per + i; if (u >= nunits) break;
        unit(u / 128, (u / 16) % 8, u % 16, qm, kvm, kpe, ao, shm); }
}
#undef MLA_WAIT_BAR
}

namespace na {
using mla::f32x16; using mla::s16x4; using mla::lds_cptr; using mla::crow; using mla::glds16; using mla::vtr;
constexpr int KSLOT = 8192, VSLOT = 8192, NSLOT = 3;
constexpr int L_K = 0, L_V = NSLOT * KSLOT, L_WS = L_V + NSLOT * VSLOT, L_OST = L_WS + 8 * 64 * 4, L_TAB = L_OST + 8 * 4096, L_END = L_TAB + 16 * 32 * 4;
constexpr float THR = 5.0f;
#define NA_WAIT_BAR(N) asm volatile("s_waitcnt vmcnt(" #N ") lgkmcnt(0)\n\ts_barrier" ::: "memory")
__device__ __forceinline__ int clampi(int v, int lo, int hi) { return v < lo ? lo : (v > hi ? hi : v); }
__device__ __forceinline__ void unit(int b, int h, int r0, const bf16_t* __restrict__ QKV, const float* __restrict__ rpb, bf16_t* __restrict__ AO, unsigned char* shm) {
    const int tid = threadIdx.x, lane = tid & 63, r32 = lane & 31, hi = lane >> 5; const int wid = __builtin_amdgcn_readfirstlane(tid >> 6);
    const size_t rowbase = (size_t)b * SEQ;
    const unsigned lds0 = (unsigned)(uintptr_t)shm;
    const lds_cptr shm3 = (lds_cptr)shm;
    LAS float* wsf = (LAS float*)(shm3 + L_WS) + wid * 64;
    LAS float* tab = (LAS float*)(shm3 + L_TAB);
    const int r = r0 + (wid >> 1), c = 32 * (wid & 1) + r32;
    const int rs = clampi(r - 4, 0, 56), cs = clampi(c - 8, 0, 48);
    const int y0 = clampi(r0 - 4, 0, 56), y1 = clampi(r0 + 3 - 4, 0, 56) + 7, nt = y1 - y0 + 1;
    for (int e = tid; e < 15 * 32; e += NTHREADS) { const int br = e >> 5, j = e & 31; tab[e] = j < 31 ? rpb[(h * 15 + br) * 31 + j] * LOG2E : 0.f; }
    const bf16_t* ksrc = QKV + (rowbase + (size_t)y0 * 64 + lane) * 1536 + 512 + h * 64 + wid * 8;
    const bf16_t* vsrc = QKV + (rowbase + (size_t)y0 * 64 + 16 * (wid & 3) + (lane >> 2)) * 1536 + 1024 + h * 64 + (wid >> 2) * 32 + (lane & 3) * 8;
    const unsigned kdst = lds0 + L_K + wid * 1024, vdst = lds0 + L_V + wid * 1024;
#define NA_DMA(t, s) do { glds16(ksrc + (size_t)(t) * 64 * 1536, (unsigned)__builtin_amdgcn_readfirstlane(kdst + (s) * KSLOT)); \
        glds16(vsrc + (size_t)(t) * 64 * 1536, (unsigned)__builtin_amdgcn_readfirstlane(vdst + (s) * VSLOT)); } while (0)
    NA_DMA(0, 0); NA_DMA(1, 1);
    bf16x8 qr[4];
    { const bf16_t* qp = QKV + (rowbase + (size_t)r * 64 + c) * 1536 + h * 64 + hi * 8;
#pragma unroll
      for (int d0 = 0; d0 < 4; ++d0) qr[d0] = *(const bf16x8*)(qp + d0 * 16); }
    float m = -INFINITY, l = 0.f; f32x16 o0 = {}, o1 = {};
    const lds_cptr kp0 = shm3 + L_K + hi * 1024 + r32 * 16;
    const lds_cptr vp0 = shm3 + L_V + ((lane >> 4) & 1) * 32 + (lane & 3) * 8 + (4 * hi + ((lane & 15) >> 2)) * 64;
    int slot = 0;
    for (int t = 0; t < nt; ++t) {
        if (t + 1 < nt) NA_WAIT_BAR(2); else NA_WAIT_BAR(0);
        if (t + 2 < nt) { const int s2 = slot == 0 ? 2 : slot - 1; NA_DMA(t + 2, s2); }
        const int y = y0 + t;
        if (y >= rs && y < rs + 8) {
            const lds_cptr kp = kp0 + slot * KSLOT; const lds_cptr vp = vp0 + slot * VSLOT;
            f32x16 p0 = {}, p1 = {};
#pragma unroll
            for (int d0 = 0; d0 < 4; ++d0) {
                const bf16x8 k0 = *(const LAS bf16x8*)(kp + d0 * 2048), k1 = *(const LAS bf16x8*)(kp + d0 * 2048 + 512);
                p0 = __builtin_amdgcn_mfma_f32_32x32x16_bf16(k0, qr[d0], p0, 0, 0, 0);
                p1 = __builtin_amdgcn_mfma_f32_32x32x16_bf16(k1, qr[d0], p1, 0, 0, 0);
            }
            const LAS float* brow = tab + (y - r + 7) * 32 + (15 - c);
#pragma unroll
            for (int rr = 0; rr < 16; ++rr) {
                const int kc0 = crow(rr, hi), kc1 = kc0 + 32;
                const bool v0 = (kc0 >= cs) && (kc0 < cs + 16), v1 = (kc1 >= cs) && (kc1 < cs + 16);
                const float b0 = brow[v0 ? kc0 : cs], b1 = brow[v1 ? kc1 : cs];
                p0[rr] = v0 ? p0[rr] + b0 : -INFINITY; p1[rr] = v1 ? p1[rr] + b1 : -INFINITY;
            }
            float rm = fmaxf(p0[0], p1[0]);
#pragma unroll
            for (int rr = 1; rr < 16; ++rr) rm = fmaxf(rm, fmaxf(p0[rr], p1[rr]));
            { auto sw = __builtin_amdgcn_permlane32_swap(__float_as_uint(rm), __float_as_uint(rm), false, false); rm = fmaxf(__uint_as_float(sw[0]), __uint_as_float(sw[1])); }
            if (__any(rm > m + THR)) {
                const float mn = fmaxf(m, rm), f = __builtin_amdgcn_exp2f(m - mn);
                m = mn; l *= f;
                if (hi == 0) wsf[r32] = f;
                asm volatile("s_waitcnt lgkmcnt(0)" ::: "memory");
#pragma unroll
                for (int rr = 0; rr < 16; ++rr) { const float fr_ = wsf[crow(rr, hi)]; o0[rr] *= fr_; o1[rr] *= fr_; }
            }
            float sacc = 0.f;
#pragma unroll
            for (int rr = 0; rr < 16; ++rr) { p0[rr] = __builtin_amdgcn_exp2f(p0[rr] - m); p1[rr] = __builtin_amdgcn_exp2f(p1[rr] - m); sacc += p0[rr] + p1[rr]; }
            l += sacc;
            const u32x4 pw0 = {pk2(p0[0], p0[1]), pk2(p0[2], p0[3]), pk2(p0[4], p0[5]), pk2(p0[6], p0[7])};
            const u32x4 pw1 = {pk2(p0[8], p0[9]), pk2(p0[10], p0[11]), pk2(p0[12], p0[13]), pk2(p0[14], p0[15])};
            const u32x4 pw2 = {pk2(p1[0], p1[1]), pk2(p1[2], p1[3]), pk2(p1[4], p1[5]), pk2(p1[6], p1[7])};
            const u32x4 pw3 = {pk2(p1[8], p1[9]), pk2(p1[10], p1[11]), pk2(p1[12], p1[13]), pk2(p1[14], p1[15])};
#define NA_PV(O, D0, KS, PW) do { const s16x4 lo_ = vtr(vp + ((D0) * 4096 + (KS) * 1024)), hi_ = vtr(vp + ((D0) * 4096 + (KS) * 1024 + 512)); \
            const bf16x8 vf_ = {lo_[0], lo_[1], lo_[2], lo_[3], hi_[0], hi_[1], hi_[2], hi_[3]}; \
            O = __builtin_amdgcn_mfma_f32_32x32x16_bf16(__builtin_bit_cast(bf16x8, PW), vf_, O, 0, 0, 0); } while (0)
            NA_PV(o0, 0, 0, pw0); NA_PV(o1, 1, 0, pw0); NA_PV(o0, 0, 1, pw1); NA_PV(o1, 1, 1, pw1);
            NA_PV(o0, 0, 2, pw2); NA_PV(o1, 1, 2, pw2); NA_PV(o0, 0, 3, pw3); NA_PV(o1, 1, 3, pw3);
#undef NA_PV
        }
        slot = slot == 2 ? 0 : slot + 1;
    }
    { auto sw = __builtin_amdgcn_permlane32_swap(__float_as_uint(l), __float_as_uint(l), false, false); l = __uint_as_float(sw[0]) + __uint_as_float(sw[1]); }
    if (hi == 0) wsf[32 + r32] = l;
    asm volatile("s_waitcnt lgkmcnt(0)" ::: "memory");
    LAS bf16_t* stg = (LAS bf16_t*)(shm3 + L_OST) + wid * 2048;
#pragma unroll
    for (int rr = 0; rr < 16; ++rr) { const int orow = crow(rr, hi); const float il = __builtin_amdgcn_rcpf(wsf[32 + orow]);
        stg[orow * 64 + r32] = (bf16_t)f2bf(o0[rr] * il); stg[orow * 64 + 32 + r32] = (bf16_t)f2bf(o1[rr] * il); }
    asm volatile("s_waitcnt lgkmcnt(0)" ::: "memory");
    bf16_t* Ow = AO + (rowbase + (size_t)r * 64 + 32 * (wid & 1)) * 1024 + h * 64;
#pragma unroll
    for (int i = 0; i < 4; ++i) { const int row = i * 8 + (lane >> 3), ch = lane & 7; const u32x4 v = *(const LAS u32x4*)(stg + row * 64 + ch * 8); *(u32x4*)(Ow + (size_t)row * 1024 + ch * 8) = v; }
    asm volatile("s_waitcnt lgkmcnt(0)\n\ts_barrier" ::: "memory");
#undef NA_DMA
}
__device__ __forceinline__ void phase(const Params& p, unsigned char* shm, int bid, int nb) {
    const int vcu = (nb % 8 == 0) ? (bid % 8) * (nb / 8) + bid / 8 : bid;
    const bf16_t* qkv = (const bf16_t*)(p.ws + WS_QKV); bf16_t* ao = (bf16_t*)(p.ws + WS_AO);
    const int nunits = 4 * 8 * 16, per = (nunits + nb - 1) / nb;
    for (int i = 0; i < per; ++i) { const int u = vcu * per + i; if (u >= nunits) break;
        unit(u / 128, (u / 16) % 8, (u % 16) * 4, qkv, p.rpb, ao, shm); }
}
#undef NA_WAIT_BAR
}

__device__ void stage_ln(float* y, const float* __restrict__ g, const float* __restrict__ bta, bf16_t* ob, int bid, int nb) {
    const int lane = threadIdx.x & 63, gw = bid * (blockDim.x >> 6) + (threadIdx.x >> 6), ngw = nb * (blockDim.x >> 6);
    for (int row = gw; row < M; row += ngw) {
        f32x4* yr = (f32x4*)(y + (size_t)row * DM) + lane;
        f32x4 v[4]; float s = 0.f;
#pragma unroll
        for (int j = 0; j < 4; ++j) { v[j] = yr[64 * j]; s += (v[j][0] + v[j][1]) + (v[j][2] + v[j][3]); }
#if PROBE_F64LN
        double sd = 0.0;
#pragma unroll
        for (int j = 0; j < 4; ++j) sd += ((double)v[j][0] + (double)v[j][1]) + ((double)v[j][2] + (double)v[j][3]);
#pragma unroll
        for (int o = 1; o < 64; o <<= 1) sd += __shfl_xor(sd, o);
        const double meand = sd / DM; double s2d = 0.0;
#pragma unroll
        for (int j = 0; j < 4; ++j)
#pragma unroll
            for (int e = 0; e < 4; ++e) { const double d_ = (double)v[j][e] - meand; s2d += d_ * d_; }
#pragma unroll
        for (int o = 1; o < 64; o <<= 1) s2d += __shfl_xor(s2d, o);
        const float mean = (float)meand; const float rstd = (float)(1.0 / sqrt(s2d / DM + (double)LN_EPS));
#pragma unroll
        for (int j = 0; j < 4; ++j) v[j] = v[j] - mean;
#else
        const float mean = wave_sum(s) * (1.f / DM); float s2 = 0.f;
#pragma unroll
        for (int j = 0; j < 4; ++j) { v[j] = v[j] - mean; s2 += (v[j][0] * v[j][0] + v[j][1] * v[j][1]) + (v[j][2] * v[j][2] + v[j][3] * v[j][3]); }
        const float rstd = rsqrtf(wave_sum(s2) * (1.f / DM) + LN_EPS);
#endif
#pragma unroll
        for (int j = 0; j < 4; ++j) {
            const f32x4 gg = ((const f32x4*)g)[lane + 64 * j], bb = ((const f32x4*)bta)[lane + 64 * j];
            const f32x4 o = v[j] * rstd * gg + bb;
            yr[64 * j] = o;
            if (ob) *(u32x2*)(ob + (size_t)row * DM + 4 * (lane + 64 * j)) = (u32x2){pk2(o[0], o[1]), pk2(o[2], o[3])};
        }
    }
}

#if PROBE_F32FFN || PROBE_F32G1
template <bool DUAL, class Epi>
__device__ void gemm_f32(const float* __restrict__ A, int lda, const float* __restrict__ B, int ldb, int K, int N, int dual_off, float* smem, const Epi& epi, int bid, int nb) {
    float* As = smem; float* Bs = smem + 16 * 68; float* Bs2 = Bs + 16 * 132;
    const int tid = threadIdx.x, ty = tid >> 5, tx = tid & 31, ntn = N / 128, ntm = M / 64;
    for (int t = bid; t < ntm * ntn; t += nb) {
        const int tm = t / ntn, tn = t % ntn;
        float acc[4][4], acc2[4][4];
#pragma unroll
        for (int i = 0; i < 4; ++i)
#pragma unroll
            for (int j = 0; j < 4; ++j) { acc[i][j] = 0.f; acc2[i][j] = 0.f; }
        for (int k0 = 0; k0 < K; k0 += 16) {
            __syncthreads();
            if (tid < 256) { const int r = tid >> 2, kk = (tid & 3) * 4; const f32x4 v = *(const f32x4*)(A + (size_t)(tm * 64 + r) * lda + k0 + kk);
              As[(kk + 0) * 68 + r] = v[0]; As[(kk + 1) * 68 + r] = v[1]; As[(kk + 2) * 68 + r] = v[2]; As[(kk + 3) * 68 + r] = v[3]; }
            { const int kk = tid >> 5, n4 = (tid & 31) * 4; *(f32x4*)(Bs + kk * 132 + n4) = (tn * 128 + n4 < ldb) ? *(const f32x4*)(B + (size_t)(k0 + kk) * ldb + tn * 128 + n4) : (f32x4){0.f, 0.f, 0.f, 0.f};
              if constexpr (DUAL) *(f32x4*)(Bs2 + kk * 132 + n4) = *(const f32x4*)(B + (size_t)(k0 + kk) * ldb + dual_off + tn * 128 + n4); }
            __syncthreads();
#pragma unroll 4
            for (int k = 0; k < 16; ++k) {
                const f32x4 a0 = *(const f32x4*)(As + k * 68 + ty * 4), b = *(const f32x4*)(Bs + k * 132 + tx * 4);
                f32x4 b2 = b; if constexpr (DUAL) b2 = *(const f32x4*)(Bs2 + k * 132 + tx * 4);
#pragma unroll
                for (int i = 0; i < 4; ++i)
#pragma unroll
                    for (int j = 0; j < 4; ++j) { acc[i][j] += a0[i] * b[j]; if constexpr (DUAL) acc2[i][j] += a0[i] * b2[j]; }
            }
        }
#pragma unroll
        for (int i = 0; i < 4; ++i)
#pragma unroll
            for (int j = 0; j < 4; ++j) epi(tm * 64 + ty * 4 + i, tn * 128 + tx * 4 + j, acc[i][j], acc2[i][j]);
    }
}
struct EpiF32H { bf16_t *qkv, *lat, *g;
    __device__ __forceinline__ void operator()(int row, int col, float v, float) const {
        if (col < 512) v *= 0.125f * LOG2E;
        const bf16_t b = (bf16_t)f2bf(v);
        if (col < 1536) qkv[(size_t)row * 1536 + col] = b;
        else if (col < 1792) lat[(size_t)row * 512 + (col - 1536)] = b;
        else if (col < 1920) lat[(size_t)row * 512 + 256 + (col - 1792)] = b;
        else if (col < 1952) { const int s_ = col - 1920, part = s_ >> 4, odd = (s_ >> 3) & 1, i = s_ & 7; lat[(size_t)row * 512 + 384 + part * 16 + 2 * i + odd] = b; }
        else if (col < 2976) g[(size_t)row * 2048 + (col - 1952)] = b;
        else if (col < 4000) g[(size_t)row * 2048 + 1024 + (col - 2976)] = b;
    } };
struct EpiF32Swiglu { float* hid; __device__ __forceinline__ void operator()(int row, int col, float g, float u) const { hid[(size_t)row * FFH + col] = g / (1.f + __expf(-g)) * u; } };
struct EpiF32Res { float* y; __device__ __forceinline__ void operator()(int row, int col, float v, float) const { const size_t o = (size_t)row * DM + col; y[o] = DN_ALPHA * y[o] + v; } };
#endif

#define XB_TMO      128
#define XB_XCNT(j)  (256  + 64 * (j))
#define XB_XSUB(j)  (1280 + 64 * (j))
#define XB_XGEN(j)  (2304 + 64 * (j))
#define XB_TOP      3328
#define XB_TOPGEN   3392
#define XCD_BAR_WORDS 3456
#define XB_SPIN_CAP (1u << 18)

__device__ __forceinline__ unsigned xb_ld(unsigned* p)              { return __hip_atomic_load(p, __ATOMIC_RELAXED, __HIP_MEMORY_SCOPE_AGENT); }
__device__ __forceinline__ unsigned xb_add(unsigned* p, unsigned v) { return __hip_atomic_fetch_add(p, v, __ATOMIC_RELAXED, __HIP_MEMORY_SCOPE_AGENT); }
__device__ __forceinline__ unsigned xb_xcc_id() { return (unsigned)__builtin_amdgcn_s_getreg((3 << 11) | 20) & 0xFu; }
#define XB_SPIN(cond, bar) do { unsigned _sp = 0; while (cond) { __builtin_amdgcn_s_sleep(1); \
    if ((++_sp & 255u) == 0u) { if (xb_ld(&(bar)[XB_TMO])) break; if (_sp > XB_SPIN_CAP) { atomicAdd(&(bar)[XB_TMO], 1u); break; } } } } while (0)

struct XcdBarrier {
    unsigned* bar; unsigned x;
    volatile LAS unsigned* st;
};

__device__ __forceinline__ XcdBarrier xcd_barrier_post(unsigned* bar, volatile LAS unsigned* st) {
    XcdBarrier b; b.bar = bar; b.x = xb_xcc_id(); b.st = st;
    if (threadIdx.x == 0) (void)xb_add(&bar[XB_XCNT(b.x)], 1u);
    return b;
}
__device__ __forceinline__ void xcd_barrier_complete(unsigned* bar, unsigned x, unsigned& nloc, unsigned& nx) {
    const unsigned G = gridDim.x * gridDim.y * gridDim.z;
    unsigned sum, cnt, mine, sp = 0u;
    for (;;) {
        sum = 0u; cnt = 0u; mine = 0u;
#pragma unroll
        for (unsigned j = 0; j < 16; ++j) { const unsigned c = xb_ld(&bar[XB_XCNT(j)]); sum += c; cnt += (c > 0u) ? 1u : 0u; mine = (j == x) ? c : mine; }
        if (sum == G) break;
        __builtin_amdgcn_s_sleep(1);
        if ((++sp & 255u) == 0u) { if (xb_ld(&bar[XB_TMO])) break; if (sp > XB_SPIN_CAP) { atomicAdd(&bar[XB_TMO], 1u); break; } }
    }
    nloc = mine > 0u ? mine : 1u; nx = cnt > 0u ? cnt : 1u;
}

__device__ __forceinline__ void xcd_barrier(const XcdBarrier& b) {
    asm volatile("s_waitcnt vmcnt(0)" ::: "memory");
    __syncthreads();
    if (threadIdx.x == 0) {
        unsigned* bar = b.bar;
        __builtin_amdgcn_s_waitcnt(0);
        unsigned nloc = b.st[0], nx = b.st[1];
        if (nloc == 0u) { xcd_barrier_complete(bar, b.x, nloc, nx); b.st[0] = nloc; b.st[1] = nx; }
        const unsigned old = xb_add(&bar[XB_XSUB(b.x)], 1u);
        const unsigned gen = old / nloc;
        if (old + 1u == (gen + 1u) * nloc) {
            __builtin_amdgcn_fence(__ATOMIC_RELEASE, "agent");
            asm volatile("s_waitcnt vmcnt(0)" ::: "memory");
            const unsigned og = xb_add(&bar[XB_TOP], 1u);
            const unsigned tg = og / nx;
            if (og + 1u == (tg + 1u) * nx) xb_add(&bar[XB_TOPGEN], 1u);
            else XB_SPIN(xb_ld(&bar[XB_TOPGEN]) == tg, bar);
            __builtin_amdgcn_fence(__ATOMIC_ACQUIRE, "agent");
            xb_add(&bar[XB_XGEN(b.x)], 1u);
            asm volatile("s_waitcnt vmcnt(0)" ::: "memory");
        } else {
            XB_SPIN(xb_ld(&bar[XB_XGEN(b.x)]) == gen, bar);
            __builtin_amdgcn_fence(__ATOMIC_ACQUIRE, "agent");
            asm volatile("s_waitcnt vmcnt(0)" ::: "memory");
        }
    }
    __syncthreads();
}


constexpr int NPHASE = 12;
constexpr int LDS_BYTES = 132 * 1024;
__global__ void __launch_bounds__(NTHREADS, 2) fwd_megakernel(Params p) {
    extern __shared__ __attribute__((aligned(16))) unsigned char lds[];
    cg::grid_group grid = cg::this_grid();
    const int bid = blockIdx.x, nb = gridDim.x;
    LAS unsigned char* ring = (LAS unsigned char*)lds;
    float* smem = (float*)lds;
    unsigned char* ws = p.ws;
    volatile LAS unsigned* bst = (volatile LAS unsigned*)(ring + 131072 + 64);
    if (threadIdx.x < 2) bst[threadIdx.x] = 0u;
    __syncthreads();
    const XcdBarrier bar = xcd_barrier_post((unsigned*)ws, bst);
#define IN(k) (p.ph_lo <= (k) && (k) < p.ph_hi)
#define SEAM(k) do { if (IN(k) && IN((k) + 1)) { if ((k) == 0) grid.sync(); else xcd_barrier(bar); } } while (0)
#define BF(off) ((bf16_t*)(ws + (off)))
    typedef pg8::StaticOrder SO;
    if (IN(0)) { stage0(p, smem, bid, nb); if (REP == 8) { grid.sync(); stage0(p, smem, bid, nb); } }
    SEAM(0);
#if PROBE_F32G1
    if (IN(1)) { gemm_f32<false>(p.x, DM, p.w_in, 4000, DM, 4096, 0, smem, EpiF32H{BF(WS_QKV), BF(WS_LAT), BF(WS_G)}, bid, nb);
        for (int i = bid * NTHREADS + threadIdx.x; i < M * 96; i += nb * NTHREADS) BF(WS_LAT)[(size_t)(i / 96) * 512 + 416 + (i % 96)] = 0; }
#else
    if (IN(1)) { pg8::Gemm g{BF(WS_XB), BF(WS_WIN), M, HP, DM, DM, DM}; SO S; S.init(M, HP, nb, bid); EpiG1 E{BF(WS_QKV), BF(WS_LAT), BF(WS_G)};
        pg8::gemm_phase<EpiG1, SO, true, true>(ring, g, S, E); if (REP == 1) { grid.sync(); pg8::gemm_phase<EpiG1, SO, true, true>(ring, g, S, E); } }
#endif
    SEAM(1);
    if (IN(2)) stage_lat(p, bid, nb);
    SEAM(2);
    if (IN(3)) for (int rep_ = 0; rep_ < (REP == 2 ? 2 : 1); ++rep_) {
        if (rep_) grid.sync();
        { pg8::Gemm g{BF(WS_LAT) + 256, BF(WS_WUKV), M, 1024, 256, 512, 256}; SO S; S.init(M, 1024, nb, bid); EpiPlain E{BF(WS_KVM), 1024};
          pg8::gemm_phase<EpiPlain, SO, true, true>(ring, g, S, E); }
        { pg8::Gemm g{BF(WS_LAT), BF(WS_WUQ), M, 768, 256, 512, 256}; SO S; S.init(M, 768, nb, (bid + 64) % nb); EpiQ E{BF(WS_QM), (const float*)(ws + WS_ROPE)};
          pg8::gemm_phase<EpiQ, SO, true, true>(ring, g, S, E); }
    }
    SEAM(3);
    if (IN(4)) { na::phase(p, lds, bid, nb); if (REP == 3) { grid.sync(); na::phase(p, lds, bid, nb); } mla::phase(p, lds, bid, nb); if (REP == 4) { grid.sync(); mla::phase(p, lds, bid, nb); } }
    SEAM(4);
    if (IN(5)) { pg8::Gemm g{BF(WS_AO), BF(WS_WBNA), M, DM, 512, 1024, 512}; SO S; S.init(M, DM, nb, bid); EpiGate<false> E{BF(WS_MG), BF(WS_G), p.b_gate};
        pg8::gemm_phase<EpiGate<false>, SO, true, true>(ring, g, S, E); if (REP == 5) { grid.sync(); pg8::gemm_phase<EpiGate<false>, SO, true, true>(ring, g, S, E); } }
    SEAM(5);
    if (IN(6)) { pg8::Gemm g{BF(WS_AO) + 512, BF(WS_WBMLA), M, DM, 512, 1024, 512}; SO S; S.init(M, DM, nb, bid); EpiGate<true> E{BF(WS_MG), BF(WS_G), p.b_gate};
        pg8::gemm_phase<EpiGate<true>, SO, true, true>(ring, g, S, E); }
    SEAM(6);
    if (IN(7)) { pg8::Gemm g{BF(WS_MG), BF(WS_WOUT), M, DM, DM, DM, DM}; SO S; S.init(M, DM, nb, bid); EpiRes E{p.x, p.out};
        pg8::gemm_phase<EpiRes, SO, true, true>(ring, g, S, E); if (REP == 6) { grid.sync(); pg8::gemm_phase<EpiRes, SO, true, true>(ring, g, S, E); } }
    SEAM(7);
    if (IN(8)) stage_ln(p.out, p.ln1g, p.ln1b, BF(WS_X1B), bid, nb);
    SEAM(8);
#if PROBE_F32FFN
    if (IN(9)) gemm_f32<true>(p.out, DM, p.w_fi, 2 * FFH, DM, FFH, FFH, smem, EpiF32Swiglu{(float*)(ws + 32 * MiB)}, bid, nb);
    SEAM(9);
    if (IN(10)) gemm_f32<false>((const float*)(ws + 32 * MiB), FFH, p.w_fo, DM, FFH, DM, 0, smem, EpiF32Res{p.out}, bid, nb);
#else
    if (IN(9)) { pg8::Gemm g{BF(WS_X1B), BF(WS_WFI), M, 2 * FFH, DM, DM, DM}; SO S; S.init(M, 2 * FFH, nb, bid); EpiSwiglu E{BF(WS_HID)};
        pg8::gemm_phase<EpiSwiglu, SO, true, true>(ring, g, S, E); if (REP == 7) { grid.sync(); pg8::gemm_phase<EpiSwiglu, SO, true, true>(ring, g, S, E); } }
    SEAM(9);
    if (IN(10)) { pg8::Gemm g{BF(WS_HID), BF(WS_WFO), M, DM, FFH, FFH, FFH}; SO S; S.init(M, DM, nb, bid); EpiRes E{p.out, p.out};
        pg8::gemm_phase<EpiRes, SO, true, true>(ring, g, S, E); }
#endif
    SEAM(10);
    if (IN(11)) stage_ln(p.out, p.ln2g, p.ln2b, nullptr, bid, nb);
    if (REP == 9) for (int i_ = 0; i_ < 10; ++i_) xcd_barrier(bar);
#if PROBE_XBITS
    {
        grid.sync();
        unsigned* cnt = (unsigned*)(ws + 32768);
        if (bid == 0 && threadIdx.x == 0) *cnt = 0u;
        grid.sync();
        const unsigned* src = (const unsigned*)(PROBE_XBITS == 1 ? p.x : p.w_out); const size_t n = PROBE_XBITS == 1 ? (size_t)M * DM : (size_t)DM * DM;
        unsigned local = 0;
        for (size_t i = (size_t)bid * NTHREADS + threadIdx.x; i < n; i += (size_t)nb * NTHREADS) local += (src[i] & 0xffffu) != 0u;
        if (local) atomicAdd(cnt, local);
        grid.sync();
        const unsigned total = __hip_atomic_load(cnt, __ATOMIC_RELAXED, __HIP_MEMORY_SCOPE_AGENT);
        if (total == 0u) for (size_t i = (size_t)bid * NTHREADS + threadIdx.x; i < (size_t)M * DM; i += (size_t)nb * NTHREADS) p.out[i] = 0.f;
    }
#endif
#undef IN
#undef SEAM
#undef BF
}

extern "C" void kernel_launch(void* const* d_in, const int* in_sizes, int n_in, void* d_out, int out_size, void* d_ws, size_t ws_size, hipStream_t stream) {
    if (n_in != 17 || out_size != M * DM || ws_size < WS_END) { fprintf(stderr, "kernel_launch: unexpected shapes (n_in %d, out %d, ws %zu)\n", n_in, out_size, ws_size); return; }
    Params p{};
    p.x = (const float*)d_in[0]; p.w_in = (const float*)d_in[1]; p.b_gate = (const float*)d_in[2]; p.rpb = (const float*)d_in[3]; p.qn = (const float*)d_in[4];
    p.w_uq = (const float*)d_in[5]; p.kvn = (const float*)d_in[6]; p.w_ukv = (const float*)d_in[7]; p.w_bna = (const float*)d_in[8]; p.w_bmla = (const float*)d_in[9];
    p.w_out = (const float*)d_in[10]; p.ln1g = (const float*)d_in[11]; p.ln1b = (const float*)d_in[12]; p.w_fi = (const float*)d_in[13]; p.w_fo = (const float*)d_in[14];
    p.ln2g = (const float*)d_in[15]; p.ln2b = (const float*)d_in[16];
    p.out = (float*)d_out; p.ws = (unsigned char*)d_ws;
    static int grid_blocks = 0;
    if (!grid_blocks) {
        int dev = 0, cus = 0, per_cu = 0;
        hipGetDevice(&dev);
        hipDeviceGetAttribute(&cus, hipDeviceAttributeMultiprocessorCount, dev);
        hipFuncSetAttribute((const void*)fwd_megakernel, hipFuncAttributeMaxDynamicSharedMemorySize, LDS_BYTES);
        hipOccupancyMaxActiveBlocksPerMultiprocessor(&per_cu, (const void*)fwd_megakernel, NTHREADS, LDS_BYTES);
        if (per_cu < 1) per_cu = 1;
        grid_blocks = cus * per_cu;
    }
    hipMemsetAsync(d_ws, 0, 16384, stream);
#if FUSED
    p.ph_lo = 0; p.ph_hi = NPHASE;
    void* args[] = {&p};
    hipError_t e = hipLaunchCooperativeKernel((const void*)fwd_megakernel, dim3(grid_blocks), dim3(NTHREADS), args, LDS_BYTES, stream);
    if (e != hipSuccess) fprintf(stderr, "cooperative launch failed: %s (grid %d)\n", hipGetErrorString(e), grid_blocks);
#else
    for (int ph = 0; ph < NPHASE; ++ph) { p.ph_lo = ph; p.ph_hi = ph + 1; hipLaunchKernelGGL(fwd_megakernel, dim3(grid_blocks), dim3(NTHREADS), LDS_BYTES, stream, p); }
#endif
}
```
